# Optimizing an MI355X kernel written in HIP

```python
import jax, jax.numpy as jnp
from jax import lax
import numpy as np

D_MODEL = 1024
BATCH = 16
SEQ = 2048
DEPTH = 1

HEAD_DIM = 64
H_FOX = 8
H_DSA = 8
W_FOX = H_FOX * HEAD_DIM
W_DSA = H_DSA * HEAD_DIM
MIX_WIDTH = W_FOX + W_DSA
H_IDX = 8
D_IDX = 64
TOPK_MAX = 256
Q_BLOCK = 128
EPS = 1e-6

IN_WIDTHS = (
    W_FOX, W_FOX, W_FOX,
    H_FOX,
    W_FOX,
    W_DSA, W_DSA, W_DSA,
    H_IDX * D_IDX,
    D_IDX,
    H_IDX,
    W_DSA,
)
N_IN = sum(IN_WIDTHS)
IN_SPLITS = tuple(int(v) for v in np.cumsum(IN_WIDTHS)[:-1])

kernel_name = "hybrid_fox_dsa_adaln_block"


def _rmsnorm(x, gain):
    x32 = x.astype(jnp.float32)
    y = x32 * lax.rsqrt(jnp.mean(x32 * x32, axis=-1, keepdims=True) + EPS)
    return y.astype(x.dtype) * gain


def _to_blocks(a):
    b, s = a.shape[:2]
    return jnp.swapaxes(a.reshape(b, s // Q_BLOCK, Q_BLOCK, *a.shape[2:]), 0, 1)


def _from_blocks(a):
    a = jnp.swapaxes(a, 0, 1)
    return a.reshape(a.shape[0], -1, *a.shape[3:])


def _alibi_slopes(n_heads):
    i = jnp.arange(1, n_heads + 1, dtype=jnp.float32)
    return jnp.exp2(-8.0 * i / n_heads)


def fox_attention(q, k, v, log_f):
    s_len = q.shape[1]
    scale = HEAD_DIM ** -0.5
    cum_f = jnp.cumsum(log_f.astype(jnp.float32), axis=1)
    cum_f_keys = jnp.swapaxes(cum_f, 1, 2)
    pos = jnp.arange(s_len)

    def block(args):
        qb, fq, tq = args
        logits = jnp.einsum('bqhd,bshd->bhqs', qb, k).astype(jnp.float32) * scale
        logits = logits + (jnp.swapaxes(fq, 1, 2)[..., :, None] - cum_f_keys[..., None, :])
        causal = pos[None, :] <= tq[:, None]
        logits = jnp.where(causal[None, None], logits, -jnp.inf)
        p = jax.nn.softmax(logits, axis=-1).astype(v.dtype)
        return jnp.einsum('bhqs,bshd->bqhd', p, v)

    out = lax.map(block, (_to_blocks(q), _to_blocks(cum_f), pos.reshape(-1, Q_BLOCK)))
    return _from_blocks(out)


def dsa_attention(q, k, v, q_idx, k_idx, w_idx):
    s_len = q.shape[1]
    top_k = min(TOPK_MAX, s_len // 4)
    scale = HEAD_DIM ** -0.5
    idx_scale = (D_IDX ** -0.5) * (H_IDX ** -0.5)
    slopes = _alibi_slopes(H_DSA)
    pos = jnp.arange(s_len)
    gather = jax.vmap(lambda arr, ii: arr[ii])

    def block(args):
        qb, qib, wb, tq = args
        s_h = jnp.einsum('bqhi,bsi->bqhs', qib, k_idx).astype(jnp.float32)
        index_score = jnp.einsum('bqh,bqhs->bqs', wb.astype(jnp.float32), jax.nn.relu(s_h)) * idx_scale
        causal = pos[None, :] <= tq[:, None]
        index_score = jnp.where(causal[None], index_score, -jnp.inf)
        _, sel = lax.top_k(index_score, top_k)
        k_sel = gather(k, sel)
        v_sel = gather(v, sel)
        logits = jnp.einsum('bqhd,bqkhd->bhqk', qb, k_sel).astype(jnp.float32) * scale
        dist = (tq[None, :, None] - sel).astype(jnp.float32)
        logits = logits - slopes[None, :, None, None] * dist[:, None]
        valid = sel <= tq[None, :, None]
        logits = jnp.where(valid[:, None], logits, -jnp.inf)
        p = jax.nn.softmax(logits, axis=-1).astype(v.dtype)
        return jnp.einsum('bhqk,bqkhd->bqhd', p, v_sel)

    out = lax.map(block, (_to_blocks(q), _to_blocks(q_idx), _to_blocks(w_idx),
                          pos.reshape(-1, Q_BLOCK)))
    return _from_blocks(out)


def setup_inputs(seed: int = 0) -> dict:
    key = jax.random.key(seed)
    ks = jax.random.split(key, 10)
    f32 = jnp.float32
    x = jax.random.normal(ks[0], (BATCH, SEQ, D_MODEL), f32)
    c = jax.random.normal(ks[1], (BATCH, D_MODEL), f32)
    w_mod = jax.random.normal(ks[2], (DEPTH, D_MODEL, 3 * D_MODEL), f32) * (0.5 * D_MODEL ** -0.5)
    b_mod = jax.random.normal(ks[3], (DEPTH, 3 * D_MODEL), f32) * 0.02
    norm_gain = 1.0 + 0.05 * jax.random.normal(ks[4], (DEPTH, D_MODEL), f32)
    w_in = jax.random.normal(ks[5], (DEPTH, D_MODEL, N_IN), f32) * (D_MODEL ** -0.5)
    b_forget = jax.random.normal(ks[6], (DEPTH, H_FOX), f32) * 0.1
    w_out = jax.random.normal(ks[7], (DEPTH, MIX_WIDTH, D_MODEL), f32) * (MIX_WIDTH ** -0.5)
    final_gain = 1.0 + 0.05 * jax.random.normal(ks[8], (D_MODEL,), f32)
    return {"x": x, "c": c, "w_mod": w_mod, "b_mod": b_mod, "norm_gain": norm_gain,
            "w_in": w_in, "b_forget": b_forget, "w_out": w_out, "final_gain": final_gain}


def reference(x, c, w_mod, b_mod, norm_gain, w_in, b_forget, w_out, final_gain):
    b, s, _ = x.shape
    c_act = jax.nn.silu(c)
    for layer in range(DEPTH):
        mod = c_act @ w_mod[layer] + b_mod[layer]
        shift, scale, gate = jnp.split(mod, 3, axis=-1)
        h = _rmsnorm(x, norm_gain[layer]) * (1.0 + scale[:, None, :]) + shift[:, None, :]

        proj = h @ w_in[layer]
        (q_a, k_a, v_a, f_logit, g_a,
         q_b, k_b, v_b, q_i, k_i, w_i, g_b) = jnp.split(proj, IN_SPLITS, axis=-1)

        log_f = jax.nn.log_sigmoid((f_logit + b_forget[layer]).astype(jnp.float32))
        y_a = fox_attention(q_a.reshape(b, s, H_FOX, HEAD_DIM),
                            k_a.reshape(b, s, H_FOX, HEAD_DIM),
                            v_a.reshape(b, s, H_FOX, HEAD_DIM), log_f).reshape(b, s, W_FOX)
        y_a = y_a * jax.nn.silu(g_a)

        y_b = dsa_attention(q_b.reshape(b, s, H_DSA, HEAD_DIM),
                            k_b.reshape(b, s, H_DSA, HEAD_DIM),
                            v_b.reshape(b, s, H_DSA, HEAD_DIM),
                            q_i.reshape(b, s, H_IDX, D_IDX), k_i, w_i).reshape(b, s, W_DSA)
        y_b = y_b * jax.nn.silu(g_b)

        y = jnp.concatenate([y_a, y_b], axis=-1) @ w_out[layer]
        x = x + gate[:, None, :] * y
    return _rmsnorm(x, final_gain)
```

```cpp
#include <hip/hip_runtime.h>
#include <hip/hip_bf16.h>
#include <cstdio>
#include <cstdint>
#include <cmath>

constexpr int BATCH = 16, SEQ = 2048, DMODEL = 1024, M_TOK = BATCH * SEQ;
constexpr int N_IN = 4688, N_INP = 4864;
constexpr float RMS_EPS = 1e-6f;
constexpr float LOG2E = 1.4426950408889634f;
constexpr float QSCALE = 0.125f * LOG2E;

namespace pg8 {
#define PG8_LAS __attribute__((address_space(3)))
typedef unsigned short bf16_t;
typedef short bf16x8 __attribute__((ext_vector_type(8)));
typedef float f32x4 __attribute__((ext_vector_type(4)));
typedef unsigned u32x4 __attribute__((ext_vector_type(4)));
constexpr int BM = 256, BK = 64, HALF = 128, HTB = HALF * BK * 2  , STAGE_BYTES = 8 * HTB, NXCD = 8, WGM = 8;

__host__ __device__ __forceinline__ int lds_byte(int r, int c) { const int st = (r >> 4) * 2 + (c >> 5), rr = r & 15, cc = c & 31, ob = rr * 64 + cc * 2; return st * 1024 + (ob ^ (((ob >> 9) & 1) << 5)); }
__host__ __device__ __forceinline__ void stage_rc(int b, int& R, int& C) { const int st = b / 1024, sb = b % 1024, swz = sb ^ (((sb >> 9) & 1) << 5); R = (st >> 1) * 16 + swz / 64; C = (st & 1) * 32 + (swz % 64) / 2; }
__host__ __device__ __forceinline__ int perm32(int rho) { const int n = rho >> 4, i = rho & 15; return 8 * (i >> 2) + 4 * n + (i & 3); }

struct Unit { int pm, pn; };
struct Gemm { const bf16_t* A; const bf16_t* Bt; int M, N, K; };

struct StaticOrder {
    int nM, nN, nwg, G, c;
    __host__ __device__ void init(int M, int N, int G_, int c_) { nM = M / BM; nN = N / BM; nwg = nM * nN; G = G_; c = c_; }
    __host__ __device__ bool next(int i, Unit& u) const {
        const long L = (long)i * G + c; if (L >= nwg) return false;
        int wgid = (int)L; { const int q = nwg / NXCD, r = nwg % NXCD, xcd = wgid % NXCD, off = wgid / NXCD; wgid = (xcd < r ? xcd * (q + 1) : r * (q + 1) + (xcd - r) * q) + off; }
        const int nig = WGM * nN, gid = wgid / nig, fm = gid * WGM, gsz = (nM - fm) < WGM ? (nM - fm) : WGM;
        u.pm = fm + ((wgid % nig) % gsz); u.pn = (wgid % nig) / gsz; return true;
    }
    __device__ __forceinline__ void a_ready(const Unit&) const {}
    __device__ __forceinline__ void done(const Unit&) const {}
};


__device__ __forceinline__ unsigned cvt_pk_bf16(float lo, float hi) { unsigned r; asm volatile("v_cvt_pk_bf16_f32 %0, %1, %2" : "=v"(r) : "v"(lo), "v"(hi)); return r; }
__device__ __forceinline__ float silu_f(float v) { return v * __builtin_amdgcn_rcpf(1.0f + __builtin_amdgcn_exp2f(-1.4426950408889634f * v)); }
__device__ __forceinline__ float logsig2_f(float x) {
    const float ls = fminf(x, 0.f) - log1pf(expf(-fabsf(x))); return ls * 1.4426950408889634f; }

struct EpiIn {
    static constexpr bool PERM = true, AFTER_DRAIN = false;
    bf16_t *Q, *K, *V, *G, *QI, *KI; float *FL, *WI; const float* bforget;
    __device__ __forceinline__ void operator()(const f32x4 (&acc)[2][2][4][2], const Unit& u, int wr, int wc, int fr, int fq) const {
        const int row0 = u.pm * BM + wr * 64 + fr; const int pn = u.pn;
        if (pn < 18) {
            bf16_t* base; int ldc, colt; int mode = 0;
            if (pn < 16) { const int t = pn >> 2; base = (t == 0) ? Q : (t == 1) ? K : (t == 2) ? V : G; ldc = 1024; colt = (pn & 3) * 256; mode = (t == 0) ? 1 : (t == 3) ? 2 : 0; }
            else { base = QI; ldc = 512; colt = (pn - 16) * 256; }
            const int col0 = colt + wc * 32 + 8 * fq;
#pragma unroll
            for (int ai = 0; ai < 2; ++ai)
#pragma unroll
                for (int m = 0; m < 4; ++m) { bf16_t* rowp = base + (size_t)(row0 + ai * HALF + m * 16) * ldc + col0;
#pragma unroll
                    for (int bj = 0; bj < 2; ++bj) { f32x4 v0 = acc[ai][bj][m][0], v1 = acc[ai][bj][m][1];
                        if (mode == 1) { v0 = v0 * QSCALE; v1 = v1 * QSCALE; }
                        else if (mode == 2) {
#pragma unroll
                            for (int j = 0; j < 4; ++j) { v0[j] = silu_f(v0[j]); v1[j] = silu_f(v1[j]); } }
                        u32x4 w; w.x = cvt_pk_bf16(v0[0], v0[1]); w.y = cvt_pk_bf16(v0[2], v0[3]); w.z = cvt_pk_bf16(v1[0], v1[1]); w.w = cvt_pk_bf16(v1[2], v1[3]);
                        *(u32x4*)(rowp + bj * HALF) = w; } }
        } else {
            const int c8 = wc * 32 + 8 * fq;
            if (c8 < 80) {
                f32x4 bf0 = (f32x4){0.f, 0.f, 0.f, 0.f}, bf1 = bf0;
                if (c8 == 0) { bf0 = *(const f32x4*)(bforget); bf1 = *(const f32x4*)(bforget + 4); }
#pragma unroll
                for (int ai = 0; ai < 2; ++ai)
#pragma unroll
                    for (int m = 0; m < 4; ++m) { const size_t row = (size_t)(row0 + ai * HALF + m * 16); f32x4 v0 = acc[ai][0][m][0], v1 = acc[ai][0][m][1];
                        if (c8 == 0) {
#pragma unroll
                            for (int j = 0; j < 4; ++j) { v0[j] = logsig2_f(v0[j] + bf0[j]); v1[j] = logsig2_f(v1[j] + bf1[j]); }
                            *(f32x4*)(FL + row * 8) = v0; *(f32x4*)(FL + row * 8 + 4) = v1;
                        } else if (c8 == 72) { *(f32x4*)(WI + row * 8) = v0; *(f32x4*)(WI + row * 8 + 4) = v1;
                        } else { u32x4 w; w.x = cvt_pk_bf16(v0[0], v0[1]); w.y = cvt_pk_bf16(v0[2], v0[3]); w.z = cvt_pk_bf16(v1[0], v1[1]); w.w = cvt_pk_bf16(v1[2], v1[3]);
                            *(u32x4*)(KI + row * 64 + (c8 - 8)) = w; } }
            }
        }
    }
};

struct EpiOut {
    static constexpr bool PERM = false, AFTER_DRAIN = false;
    const float* x; float* out; const float* gate; float* rowsq;
    __device__ __forceinline__ void operator()(const f32x4 (&acc)[2][2][4][2], const Unit& u, int wr, int wc, int fr, int fq) const {
        const int b = u.pm >> 3;
        const int col0 = u.pn * BM + wc * 32 + 4 * fq;
        f32x4 gv[2][2];
#pragma unroll
        for (int bj = 0; bj < 2; ++bj)
#pragma unroll
            for (int n = 0; n < 2; ++n) gv[bj][n] = *(const f32x4*)(gate + (size_t)b * 1024 + col0 + bj * HALF + n * 16);
#pragma unroll
        for (int ai = 0; ai < 2; ++ai)
#pragma unroll
            for (int m = 0; m < 4; ++m) { const int row = u.pm * BM + ai * HALF + wr * 64 + m * 16 + fr; const size_t off = (size_t)row * 1024 + col0; float sq = 0.f;
#pragma unroll
                for (int bj = 0; bj < 2; ++bj)
#pragma unroll
                    for (int n = 0; n < 2; ++n) { const f32x4 xv = *(const f32x4*)(x + off + bj * HALF + n * 16); const f32x4 z = xv + gv[bj][n] * acc[ai][bj][m][n];
                        *(f32x4*)(out + off + bj * HALF + n * 16) = z; sq += (z[0] * z[0] + z[1] * z[1]) + (z[2] * z[2] + z[3] * z[3]); }
                sq += __shfl_xor(sq, 16); sq += __shfl_xor(sq, 32);
                if (fq == 0) rowsq[(size_t)row * 16 + u.pn * 4 + wc] = sq;
                if (m & 1) asm volatile("" ::: "memory"); }
    }
};

template <class Epi, class Sched, bool ALIGN_EPI = false, bool SP2 = false>
__device__ __forceinline__ void gemm_phase(PG8_LAS unsigned char* lds, const Gemm g, const Sched& S, const Epi& E) {
    const int tid = threadIdx.x, wid = __builtin_amdgcn_readfirstlane(tid >> 6), lane = tid & 63, wr = wid >> 2, wc = wid & 3, fr = lane & 15, fq = lane >> 4;
    const int K = g.K, nt = K / BK;
    unsigned voffA[2], voffB[2];
#pragma unroll
    for (int i = 0; i < 2; ++i) { int R, C; stage_rc(tid * 16 + i * 8192, R, C); const int Rb = Epi::PERM ? ((R & ~31) + perm32(R & 31)) : R;
        voffA[i] = (unsigned)(R * K + C) * 2u; voffB[i] = (unsigned)(Rb * K + C) * 2u; }
    const size_t kstep = (size_t)(BK * 2);
    const size_t hstep = (size_t)HALF * K * 2;
    const size_t tstep = 2 * hstep;
    const unsigned ldsw = (unsigned)wid * 1024u;
    const int aoff = lds_byte(wr * 64 + fr, fq * 8), boff = lds_byte(wc * 32 + fr, fq * 8);
#define PG8_SA(b, h) (((b) * 2 + (h)) * HTB)
#define PG8_SB(b, h) ((4 + (b) * 2 + (h)) * HTB)
#define PG8_STAGE(bufoff, gbase, voff) do { _Pragma("unroll") for (int _i = 0; _i < 2; ++_i) \
        __builtin_amdgcn_global_load_lds((const unsigned*)((const char*)(gbase) + (voff)[_i]), (PG8_LAS unsigned*)(lds + (bufoff) + ldsw + _i * 8192), 16, 0, 0); } while (0)
#define PG8_LDA(dst, b, h) do { _Pragma("unroll") for (int m = 0; m < 4; ++m) _Pragma("unroll") for (int k = 0; k < 2; ++k) dst[m][k] = *(const PG8_LAS bf16x8*)(lds + PG8_SA(b, h) + aoff + m * 2048 + k * 1024); } while (0)
#define PG8_LDB(dst, b, h) do { _Pragma("unroll") for (int n = 0; n < 2; ++n) _Pragma("unroll") for (int k = 0; k < 2; ++k) dst[n][k] = *(const PG8_LAS bf16x8*)(lds + PG8_SB(b, h) + boff + n * 2048 + k * 1024); } while (0)
#define PG8_MMA(ai, bj, At, Bt) do { __builtin_amdgcn_s_setprio(1); _Pragma("unroll") for (int m = 0; m < 4; ++m) _Pragma("unroll") for (int n = 0; n < 2; ++n) _Pragma("unroll") for (int k = 0; k < 2; ++k) \
        acc[ai][bj][m][n] = __builtin_amdgcn_mfma_f32_16x16x32_bf16(Bt[n][k], At[m][k], acc[ai][bj][m][n], 0, 0, 0); __builtin_amdgcn_s_setprio(0); } while (0)
#define PG8_WAIT_V(n) asm volatile("s_waitcnt vmcnt(" #n ")" ::: "memory")
#define PG8_WAIT_L(n) asm volatile("s_waitcnt lgkmcnt(" #n ")" ::: "memory")
#define PG8_BAR __builtin_amdgcn_s_barrier()
#define PG8_SCHED __builtin_amdgcn_sched_barrier(0)
    Unit cur, nxt; int ui = 0;
    if (!S.next(0, cur)) return;
    f32x4 acc[2][2][4][2];
#pragma unroll
    for (int a = 0; a < 2; ++a)
#pragma unroll
        for (int b = 0; b < 2; ++b)
#pragma unroll
            for (int m = 0; m < 4; ++m)
#pragma unroll
                for (int n = 0; n < 2; ++n) acc[a][b][m][n] = (f32x4){0.f, 0.f, 0.f, 0.f};
    bf16x8 At[4][2], B0[2][2], B1[2][2];
    const char* cA = (const char*)g.A + (size_t)cur.pm * tstep; const char* cB = (const char*)g.Bt + (size_t)cur.pn * tstep;
    S.a_ready(cur);
    if constexpr (SP2) {
        PG8_STAGE(PG8_SB(0, 0), cB, voffB); PG8_STAGE(PG8_SB(0, 1), cB + hstep, voffB); PG8_STAGE(PG8_SA(0, 0), cA, voffA); PG8_STAGE(PG8_SA(0, 1), cA + hstep, voffA);
        if (wr == 1) PG8_BAR;
        PG8_WAIT_V(2); PG8_BAR;
        PG8_STAGE(PG8_SB(1, 0), cB + kstep, voffB); PG8_STAGE(PG8_SA(1, 0), cA + kstep, voffA); PG8_STAGE(PG8_SB(1, 1), cB + hstep + kstep, voffB);
        PG8_WAIT_V(6); PG8_BAR;
    } else {
        PG8_STAGE(PG8_SB(0, 0), cB, voffB); PG8_STAGE(PG8_SA(0, 0), cA, voffA); PG8_STAGE(PG8_SB(0, 1), cB + hstep, voffB); PG8_STAGE(PG8_SA(0, 1), cA + hstep, voffA);
        if (wr == 1) PG8_BAR;
        PG8_WAIT_V(4); PG8_BAR;
        PG8_STAGE(PG8_SB(1, 0), cB + kstep, voffB); PG8_STAGE(PG8_SA(1, 0), cA + kstep, voffA); PG8_STAGE(PG8_SB(1, 1), cB + hstep + kstep, voffB);
        PG8_WAIT_V(6); PG8_BAR;
    }
    for (;;) {
        const bool has_next = S.next(ui + 1, nxt);
        const char* nA = has_next ? (const char*)g.A + (size_t)nxt.pm * tstep : cA; const char* nB = has_next ? (const char*)g.Bt + (size_t)nxt.pn * tstep : cB;
        for (int t = 0; t < nt; t += 2) {
            const bool last = (t == nt - 2);
            const char* a1 = cA + (size_t)(t + 1) * kstep;
            const char* a2 = last ? nA : cA + (size_t)(t + 2) * kstep; const char* b2 = last ? nB : cB + (size_t)(t + 2) * kstep;
            const char* a3 = a2 + kstep; const char* b3 = b2 + kstep;
            if (last && has_next) S.a_ready(nxt);
            if constexpr (SP2) {
            PG8_LDB(B0, 0, 0); PG8_LDB(B1, 0, 1); PG8_SCHED; PG8_LDA(At, 0, 0); PG8_STAGE(PG8_SA(1, 1), a1 + hstep, voffA);
            PG8_WAIT_V(8); PG8_WAIT_L(0); PG8_BAR; PG8_MMA(0, 0, At, B0); PG8_MMA(0, 1, At, B1); PG8_BAR; PG8_SCHED;
            PG8_LDA(At, 0, 1); PG8_STAGE(PG8_SB(0, 0), b2, voffB); PG8_STAGE(PG8_SB(0, 1), b2 + hstep, voffB); PG8_STAGE(PG8_SA(0, 0), a2, voffA);
            PG8_WAIT_V(8); PG8_WAIT_L(0); PG8_BAR; PG8_MMA(1, 0, At, B0); PG8_MMA(1, 1, At, B1); PG8_BAR; PG8_SCHED;
            PG8_LDB(B0, 1, 0); PG8_LDB(B1, 1, 1); PG8_SCHED; PG8_LDA(At, 1, 0); PG8_STAGE(PG8_SA(0, 1), a2 + hstep, voffA);
            PG8_WAIT_V(8); PG8_WAIT_L(0); PG8_BAR; PG8_MMA(0, 0, At, B0); PG8_MMA(0, 1, At, B1); PG8_BAR; PG8_SCHED;
            PG8_LDA(At, 1, 1); PG8_STAGE(PG8_SB(1, 0), b3, voffB); PG8_STAGE(PG8_SB(1, 1), b3 + hstep, voffB); PG8_STAGE(PG8_SA(1, 0), a3, voffA);
            PG8_WAIT_V(8); PG8_WAIT_L(0); PG8_BAR; PG8_MMA(1, 0, At, B0); PG8_MMA(1, 1, At, B1); PG8_BAR; PG8_SCHED;
            } else {
            PG8_LDB(B0, 0, 0); PG8_SCHED; PG8_LDA(At, 0, 0); PG8_STAGE(PG8_SA(1, 1), a1 + hstep, voffA);
            PG8_WAIT_L(8); PG8_BAR; PG8_WAIT_L(0); PG8_MMA(0, 0, At, B0); PG8_BAR; PG8_SCHED;
            PG8_LDB(B1, 0, 1); PG8_STAGE(PG8_SB(0, 0), b2, voffB);
            PG8_BAR; PG8_WAIT_L(0); PG8_MMA(0, 1, At, B1); PG8_BAR;
            PG8_LDA(At, 0, 1); PG8_STAGE(PG8_SA(0, 0), a2, voffA);
            PG8_BAR; PG8_WAIT_L(0); PG8_MMA(1, 0, At, B0); PG8_BAR; PG8_SCHED;
            PG8_STAGE(PG8_SB(0, 1), b2 + hstep, voffB);
            PG8_WAIT_V(6); PG8_BAR; PG8_MMA(1, 1, At, B1); PG8_BAR;
            PG8_LDB(B0, 1, 0); PG8_SCHED; PG8_LDA(At, 1, 0); PG8_STAGE(PG8_SA(0, 1), a2 + hstep, voffA);
            PG8_WAIT_L(8); PG8_BAR; PG8_WAIT_L(0); PG8_MMA(0, 0, At, B0); PG8_BAR; PG8_SCHED;
            PG8_LDB(B1, 1, 1); PG8_STAGE(PG8_SB(1, 0), b3, voffB);
            PG8_BAR; PG8_WAIT_L(0); PG8_MMA(0, 1, At, B1); PG8_BAR;
            PG8_LDA(At, 1, 1); PG8_STAGE(PG8_SA(1, 0), a3, voffA);
            PG8_BAR; PG8_WAIT_L(0); PG8_MMA(1, 0, At, B0); PG8_BAR; PG8_SCHED;
            PG8_STAGE(PG8_SB(1, 1), b3 + hstep, voffB);
            PG8_WAIT_V(6); PG8_BAR; PG8_MMA(1, 1, At, B1); PG8_BAR;
            }
        }
        if constexpr (ALIGN_EPI) { if (wr == 0) PG8_BAR; }
        if constexpr (!Epi::AFTER_DRAIN) { E(acc, cur, wr, wc, fr, fq); S.done(cur); }
        if (!has_next) break;
#pragma unroll
        for (int a = 0; a < 2; ++a)
#pragma unroll
            for (int b = 0; b < 2; ++b)
#pragma unroll
                for (int m = 0; m < 4; ++m)
#pragma unroll
                    for (int n = 0; n < 2; ++n) acc[a][b][m][n] = (f32x4){0.f, 0.f, 0.f, 0.f};
        cur = nxt; cA = nA; cB = nB; ++ui;
        if constexpr (ALIGN_EPI) { if (wr == 1) PG8_BAR; }
    }
    PG8_WAIT_V(0);
    if constexpr (!ALIGN_EPI) { if (wr == 0) PG8_BAR; }
    PG8_BAR;
    if constexpr (Epi::AFTER_DRAIN) { E.fused(acc, cur, wr, wc, fr, fq, lds, wid, lane); S.done(cur); }
#undef PG8_SA
#undef PG8_SB
#undef PG8_STAGE
#undef PG8_LDA
#undef PG8_LDB
#undef PG8_MMA
#undef PG8_WAIT_V
#undef PG8_WAIT_L
#undef PG8_BAR
#undef PG8_SCHED
}
}
#include <hip/hip_bf16.h>
#include <cmath>
namespace attn_body {
using bf16=__hip_bfloat16;
using bf16x8=__attribute__((ext_vector_type(8)))short;
using s16x4=__attribute__((ext_vector_type(4)))short;
using f32x16=__attribute__((ext_vector_type(16)))float;
using u32x4=__attribute__((ext_vector_type(4)))unsigned;
using f32x4_t=__attribute__((ext_vector_type(4)))float;
constexpr int NHEAD=16,D=64,DM=NHEAD*D; using ::SEQ;
constexpr int NW=8,QBLK=32,QB=QBLK*NW,KVBLK=64,NQB=SEQ/QB;
constexpr int ATTN_PITCH=DM, ATTN_UNIT_ROWS=QB;
__device__ __forceinline__ int crow(int r,int hi){return (r&3)+8*(r>>2)+4*hi;}
#define SBAR() __builtin_amdgcn_sched_barrier(0)
__device__ __forceinline__ void cmask(f32x16&p0,f32x16&p1,int jb,int qrel,int hi){
  const float NEG=-INFINITY; int kb=64*jb+4*hi;
  #pragma unroll
  for(int r=0;r<16;++r){int kv=kb+(r&3)+8*(r>>2); if(kv>qrel)p0[r]=NEG; if(kv+32>qrel)p1[r]=NEG;}
}

constexpr int NSLOT=3, SLOTB=8192;
constexpr int LDS_K=0, LDS_V=NSLOT*SLOTB, LDS_WS=2*NSLOT*SLOTB, LDS_OST=LDS_WS+NW*64*4, LDS_BYTES=LDS_OST+NW*4096, LDS_MASK=LDS_BYTES, MASK_ROW=264, MASK_WAVE=32*MASK_ROW, LDS_BYTES_DSA=LDS_MASK+NW*MASK_WAVE;
constexpr float C2=::QSCALE;
__device__ __forceinline__ void glds16(const void*gsrc,unsigned lds_dst){unsigned keep;
  asm volatile("s_mov_b32 %0, m0\n\ts_mov_b32 m0, %2\n\ts_nop 0\n\tglobal_load_lds_dwordx4 %1, off\n\ts_mov_b32 m0, %0":"=&s"(keep):"v"(gsrc),"s"(lds_dst):"memory");}
__device__ __forceinline__ float max3f(float a,float b,float c){float r;asm("v_max3_f32 %0, %1, %2, %3":"=v"(r):"v"(a),"v"(b),"v"(c));return r;}
__device__ __forceinline__ float max2f(float a,float b){float r;asm("v_max_f32_e32 %0, %1, %2":"=v"(r):"v"(a),"v"(b));return r;}
__device__ __forceinline__ float fadd_s(float a,float b){float r;asm("v_add_f32_e32 %0, %1, %2":"=v"(r):"v"(a),"v"(b));return r;}
__device__ __forceinline__ float fsub_s(float a,float b){float r;asm("v_sub_f32_e32 %0, %1, %2":"=v"(r):"v"(a),"v"(b));return r;}
typedef float f32x2_t __attribute__((ext_vector_type(2))); typedef __bf16 bf16x2_t __attribute__((ext_vector_type(2)));
__device__ __forceinline__ unsigned cvtpk_s(float lo,float hi){f32x2_t v={lo,hi};bf16x2_t b=__builtin_convertvector(v,bf16x2_t);return __builtin_bit_cast(unsigned,b);}
#define WAIT_BAR(N) asm volatile("s_waitcnt vmcnt(" #N ") lgkmcnt(0)\n\ts_barrier":::"memory")

__device__ __forceinline__ void qkt(f32x16&p0,f32x16&p1,const char*Kslot,const bf16x8*qr,int r32,int hi){
  const char*kb=Kslot+hi*1024+r32*16;
  #pragma unroll
  for(int d0=0;d0<4;++d0){
    const bf16x8 b0=*reinterpret_cast<const bf16x8*>(kb+d0*2048);
    const bf16x8 b1=*reinterpret_cast<const bf16x8*>(kb+d0*2048+512);
    p0=__builtin_amdgcn_mfma_f32_32x32x16_bf16(b0,qr[d0],p0,0,0,0);p1=__builtin_amdgcn_mfma_f32_32x32x16_bf16(b1,qr[d0],p1,0,0,0);}
}
typedef __attribute__((address_space(3))) const char* lds_cptr;
typedef short v4i16_t __attribute__((ext_vector_type(4)));
__device__ __forceinline__ void kload8(bf16x8*kf,lds_cptr kp){
  kf[0]=*(const __attribute__((address_space(3))) bf16x8*)(kp);      kf[1]=*(const __attribute__((address_space(3))) bf16x8*)(kp+512);
  kf[2]=*(const __attribute__((address_space(3))) bf16x8*)(kp+2048); kf[3]=*(const __attribute__((address_space(3))) bf16x8*)(kp+2560);
  kf[4]=*(const __attribute__((address_space(3))) bf16x8*)(kp+4096); kf[5]=*(const __attribute__((address_space(3))) bf16x8*)(kp+4608);
  kf[6]=*(const __attribute__((address_space(3))) bf16x8*)(kp+6144); kf[7]=*(const __attribute__((address_space(3))) bf16x8*)(kp+6656);
}
__device__ __forceinline__ void kload2(bf16x8*kf,lds_cptr kp,int j){ kf[2*j]=*(const __attribute__((address_space(3))) bf16x8*)(kp+j*2048); kf[2*j+1]=*(const __attribute__((address_space(3))) bf16x8*)(kp+j*2048+512); }
__device__ __forceinline__ s16x4 vtr(lds_cptr p){ return __builtin_bit_cast(s16x4,__builtin_amdgcn_ds_read_tr16_b64_v4i16((__attribute__((address_space(3))) v4i16_t*)p)); }
__device__ __forceinline__ float rowmax(const f32x16&p0,const f32x16&p1){
  float a=max3f(p0[0],p0[1],p1[0]),b=max3f(p0[2],p0[3],p1[1]);a=max3f(a,p1[2],p1[3]);
  #pragma unroll
  for(int r=4;r<16;r+=4){a=max3f(a,p0[r],p0[r+1]);b=max3f(b,p0[r+2],p0[r+3]);a=max3f(a,p1[r],p1[r+1]);b=max3f(b,p1[r+2],p1[r+3]);}
  const float m=max2f(a,b);
  auto rr=__builtin_amdgcn_permlane32_swap(__float_as_uint(m),__float_as_uint(m),false,false);
  return max2f(__uint_as_float(rr[0]),__uint_as_float(rr[1]));
}
__device__ __forceinline__ void pv(f32x16*o,int vb,bf16x8 pa0,bf16x8 pa1,bf16x8 pa2,bf16x8 pa3){
  #pragma unroll
  for(int d0=0;d0<2;++d0){s16x4 lo[4],hi[4];
    #pragma unroll
    for(int ks=0;ks<4;++ks){
      asm volatile("ds_read_b64_tr_b16 %0,%1 offset:%c2":"=&v"(lo[ks]):"v"(vb),"i"(d0*4096+ks*1024):"memory");
      asm volatile("ds_read_b64_tr_b16 %0,%1 offset:%c2":"=&v"(hi[ks]):"v"(vb),"i"(d0*4096+ks*1024+512):"memory");}
    asm volatile("s_waitcnt lgkmcnt(0)":::"memory");SBAR();
    #define PK(k) (bf16x8){lo[k][0],lo[k][1],lo[k][2],lo[k][3],hi[k][0],hi[k][1],hi[k][2],hi[k][3]}
    o[d0]=__builtin_amdgcn_mfma_f32_32x32x16_bf16(pa0,PK(0),o[d0],0,0,0);
    o[d0]=__builtin_amdgcn_mfma_f32_32x32x16_bf16(pa1,PK(1),o[d0],0,0,0);
    o[d0]=__builtin_amdgcn_mfma_f32_32x32x16_bf16(pa2,PK(2),o[d0],0,0,0);
    o[d0]=__builtin_amdgcn_mfma_f32_32x32x16_bf16(pa3,PK(3),o[d0],0,0,0);
    #undef PK
  }
}

#ifndef ATTN_STORE16
#define ATTN_STORE16(p,v) (*(u32x4*)(p)=(v))
#endif
template<int THRL,int MODE> __device__ __forceinline__ void attn_unit(int b,int h,int qb,const bf16*Q,const bf16*__restrict__ K,const bf16*__restrict__ V,bf16*O,const bf16*__restrict__ G,char*shm,
    const float*kbl,float slope2,const unsigned long long*__restrict__ Mb){
  const int tid=threadIdx.x,lane=tid&63,r32=lane&31,hi=lane>>5; const int wid=__builtin_amdgcn_readfirstlane(tid>>6);
  const long rowbase=(long)b*SEQ; const int q0=qb*QB;
  const bf16*Qw=Q+(rowbase+q0+wid*QBLK)*DM+h*D;
  const bf16*Kh=K+rowbase*DM+h*D,*Vh=V+rowbase*DM+h*D;
  const unsigned lds0=(unsigned)(uintptr_t)shm;
  float*wsf=(float*)(shm+LDS_WS)+wid*64;
  const bf16*ksrc=Kh+(long)lane*DM+wid*8;
  const bf16*vsrc=Vh+(long)(16*(wid&3)+(lane>>2))*DM+(wid>>2)*32+(lane&3)*8;
  const unsigned kdst=lds0+LDS_K+wid*1024, vdst=lds0+LDS_V+wid*1024;
  #define DMA_K(t,slot) glds16(ksrc+(long)(t)*KVBLK*DM,(unsigned)__builtin_amdgcn_readfirstlane(kdst+(slot)))
  #define DMA_V(t,slot) glds16(vsrc+(long)(t)*KVBLK*DM,(unsigned)__builtin_amdgcn_readfirstlane(vdst+(slot)))
  const int vb0=(int)(lds0+LDS_V)+((lane>>4)&1)*32+(lane&3)*8+(4*hi+((lane&15)>>2))*64;
  const char*Kbase=shm+LDS_K; bf16x8 kf[8];
  const lds_cptr shm3=(lds_cptr)shm; const lds_cptr kp0=shm3+LDS_K+hi*1024+r32*16; const lds_cptr vp0=shm3+LDS_V+((lane>>4)&1)*32+(lane&3)*8+(4*hi+((lane&15)>>2))*64;
  const int NT=(q0+QB)/KVBLK;
  DMA_K(0,0);DMA_V(0,0);DMA_K(1,SLOTB);
  bf16x8 qr[4];
  #pragma unroll
  for(int d0=0;d0<4;++d0)qr[d0]=*reinterpret_cast<const bf16x8*>(&Qw[(long)r32*DM+d0*16+hi*8]);
  float mhat=0.f,l_reg=0.f;f32x16 o[2];o[0]=f32x16{};o[1]=f32x16{};float nm=0.f;
  typedef __attribute__((address_space(3))) const f32x4_t* lds_f4p; typedef __attribute__((address_space(3))) const unsigned long long* lds_u64p;
  const lds_f4p kb4=(lds_f4p)kbl;
  const lds_cptr mrow3=(lds_cptr)shm+LDS_MASK+wid*MASK_WAVE+r32*MASK_ROW;
  if(MODE==1){ const unsigned long long*msrc=Mb+((size_t)(q0+wid*QBLK+r32)*32+16*hi); u32x4 tm[8];
    _Pragma("unroll") for(int i=0;i<8;++i)tm[i]=*reinterpret_cast<const u32x4*>(msrc+2*i);
    __attribute__((address_space(3))) unsigned long long*md=(__attribute__((address_space(3))) unsigned long long*)((__attribute__((address_space(3))) char*)shm+LDS_MASK+wid*MASK_WAVE+r32*MASK_ROW+hi*128);
    _Pragma("unroll") for(int i=0;i<8;++i){ md[2*i]=((unsigned long long)tm[i][1]<<32)|tm[i][0]; md[2*i+1]=((unsigned long long)tm[i][3]<<32)|tm[i][2]; } }
  #define CINIT(C0,C1,t) do{ if(MODE==0){ const int i4_=16*(t)+hi; \
      _Pragma("unroll") for(int g_=0;g_<4;++g_){ const f32x4_t a_=kb4[i4_+2*g_], b_=kb4[i4_+8+2*g_]; \
        _Pragma("unroll") for(int j_=0;j_<4;++j_){ C0[4*g_+j_]=nm+a_[j_]; C1[4*g_+j_]=nm+b_[j_]; } } } \
    else { const unsigned long long w_=*(lds_u64p)(mrow3+8*(t)); const unsigned wl_=((unsigned)w_)>>(4*hi), wh_=((unsigned)(w_>>32))>>(4*hi); \
      float sl_=slope2; asm volatile("":"+v"(sl_)); const float base_=nm+sl_*(float)(64*(t)+4*hi);     \
      _Pragma("unroll") for(int r_=0;r_<16;++r_){ const int b_=(r_&3)+8*(r_>>2); \
        C0[r_]=((wl_>>b_)&1u)?__builtin_fmaf(sl_,(float)b_,base_):-INFINITY; C1[r_]=((wh_>>b_)&1u)?__builtin_fmaf(sl_,(float)(b_+32),base_):-INFINITY; } } }while(0)
  const int qrel=wid*QBLK+r32;
  #define CMASK(P0,P1,t) do{ if(MODE==0){int jb_=(t)-(NT-4); if(jb_>=0)cmask(P0,P1,jb_,qrel,hi);} }while(0)
  bool resc=false;
  #define START(P0,P1) do{ const float rm=rowmax(P0,P1); resc=false; \
    { const float dl=(MODE==1)?__builtin_fmaxf(rm,-1.0e4f):rm; mhat=fadd_s(mhat,dl); \
      _Pragma("unroll") for(int r=0;r<16;++r){P0[r]=fsub_s(P0[r],dl);P1[r]=fsub_s(P1[r],dl);} \
      nm=-mhat; } \
    _Pragma("unroll") for(int r=0;r<16;++r)P0[r]=__builtin_amdgcn_exp2f(P0[r]); }while(0)
  #define RESC() do{ if(resc){ asm volatile("s_waitcnt lgkmcnt(0)":::"memory"); \
      _Pragma("unroll") for(int d_=0;d_<2;++d_) _Pragma("unroll") for(int r=0;r<16;++r)o[d_][r]*=wsf[crow(r,hi)]; } }while(0)
  f32x16 pA0,pA1,pB0,pB1;
  int sl_prev=0,sl_cur=0,sl_next=SLOTB;
  #define ROT() do{sl_prev=sl_cur;sl_cur=sl_next;sl_next=(sl_next==(NSLOT-1)*SLOTB)?0:sl_next+SLOTB;}while(0)
  DMA_K(2,2*SLOTB);
  WAIT_BAR(3);
  CINIT(pA0,pA1,0); qkt(pA0,pA1,Kbase,qr,r32,hi);asm volatile("s_nop 15\n\ts_nop 7":"+v"(pA0),"+v"(pA1));CMASK(pA0,pA1,0);
  START(pA0,pA1);
  _Pragma("unroll") for(int r=0;r<16;++r)pA1[r]=__builtin_amdgcn_exp2f(pA1[r]);
  WAIT_BAR(0);
  DMA_K(3,0);DMA_V(1,SLOTB);
  ROT();
  kload8(kf,kp0+sl_cur);
  WAIT_BAR(2);
  s16x4 vlo[8],vhi[8]; u32x4 pw0,pw1,pw2,pw3;
  #define PKW(P,B) cvtpk_s(P[B],P[B+1])
  #define PAF(k) __builtin_bit_cast(bf16x8,pw##k)
  #define VFR(i) (bf16x8){vlo[i][0],vlo[i][1],vlo[i][2],vlo[i][3],vhi[i][0],vhi[i][1],vhi[i][2],vhi[i][3]}
  #define PIN(x) asm volatile("":"+v"(x))
  #define MX3(a,b,c) __builtin_fmaxf(__builtin_fmaxf((a),(b)),(c))
  #define GAPA(MF,A0,A1,A2,A3,W0,W1,PW) do{ MF; sacc+=A0; sacc+=A1; sacc+=A2; sacc+=A3; PIN(sacc); W0; W1; PIN(PW); SBAR(); }while(0)
  #define EX(v) __builtin_amdgcn_exp2f(v)
  #define GAPB(MF,X,B) do{ MF; X[B]=EX(X[B]); X[B+1]=EX(X[B+1]); X[B+2]=EX(X[B+2]); X[B+3]=EX(X[B+3]); PIN(X); SBAR(); }while(0)
  #define VRD(i) do{ vlo[i]=vtr(vp_+(((i)>>2)*4096+((i)&3)*1024)); vhi[i]=vtr(vp_+(((i)>>2)*4096+((i)&3)*1024+512)); }while(0)
  #define KRD(G,j) do{ if(G){ kload2(kf,kp0+sl_next,j); SBAR(); } }while(0)
  #define STEP(C0,C1,P0,P1,t,GK,GV,GL) do{ SBAR(); \
    const lds_cptr vp_=vp0+sl_prev; \
    CINIT(C0,C1,t); SBAR(); \
    VRD(0); SBAR(); float sacc=(P0[0]+P0[1]); \
    GAPA(C0=__builtin_amdgcn_mfma_f32_32x32x16_bf16(kf[0],qr[0],C0,0,0,0), P0[2],P0[3],P0[4],P0[5],     pw0[0]=PKW(P0,0), pw0[1]=PKW(P0,2), pw0); \
    VRD(4); SBAR(); GAPA(C1=__builtin_amdgcn_mfma_f32_32x32x16_bf16(kf[1],qr[0],C1,0,0,0), P0[6],P0[7],P0[8],P0[9],     pw0[2]=PKW(P0,4), pw0[3]=PKW(P0,6), pw0); \
    VRD(1); SBAR(); GAPA(C0=__builtin_amdgcn_mfma_f32_32x32x16_bf16(kf[2],qr[1],C0,0,0,0),   P0[10],P0[11],P0[12],P0[13], pw1[0]=PKW(P0,8), pw1[1]=PKW(P0,10), pw1); \
    VRD(5); SBAR(); GAPA(C1=__builtin_amdgcn_mfma_f32_32x32x16_bf16(kf[3],qr[1],C1,0,0,0),   P0[14],P0[15],P1[0],P1[1],   pw1[2]=PKW(P0,12),pw1[3]=PKW(P0,14), pw1); \
    VRD(2); SBAR(); GAPA(C0=__builtin_amdgcn_mfma_f32_32x32x16_bf16(kf[4],qr[2],C0,0,0,0),   P1[2],P1[3],P1[4],P1[5],     pw2[0]=PKW(P1,0), pw2[1]=PKW(P1,2), pw2); \
    VRD(6); SBAR(); GAPA(C1=__builtin_amdgcn_mfma_f32_32x32x16_bf16(kf[5],qr[2],C1,0,0,0),   P1[6],P1[7],P1[8],P1[9],     pw2[2]=PKW(P1,4), pw2[3]=PKW(P1,6), pw2); \
    VRD(3); SBAR(); GAPA(C0=__builtin_amdgcn_mfma_f32_32x32x16_bf16(kf[6],qr[3],C0,0,0,0),   P1[10],P1[11],P1[12],P1[13], pw3[0]=PKW(P1,8), pw3[1]=PKW(P1,10), pw3); \
    VRD(7); SBAR(); GAPA(C1=__builtin_amdgcn_mfma_f32_32x32x16_bf16(kf[7],qr[3],C1,0,0,0),   P1[14],P1[15],0.f,0.f,       pw3[2]=PKW(P1,12),pw3[3]=PKW(P1,14), pw3); \
    l_reg+=sacc; \
    if(GK){DMA_K((t)+3,sl_cur);} if(GV){DMA_V((t)+1,sl_next);} \
    CMASK(C0,C1,t); \
    { float a=MX3(C0[0],C0[1],C1[0]),b=MX3(C0[2],C0[3],C1[1]); a=MX3(a,C1[2],C1[3]); \
      _Pragma("unroll") for(int r=4;r<16;r+=4){a=MX3(a,C0[r],C0[r+1]);b=MX3(b,C0[r+2],C0[r+3]);a=MX3(a,C1[r],C1[r+1]);b=MX3(b,C1[r+2],C1[r+3]);} \
      float rm=__builtin_fmaxf(a,b); { auto rr=__builtin_amdgcn_permlane32_swap(__float_as_uint(rm),__float_as_uint(rm),false,false); rm=__builtin_fmaxf(__uint_as_float(rr[0]),__uint_as_float(rr[1])); } \
      resc=false; \
      if(__builtin_expect(__any(rm>(float)THRL),0)){ const float dl=__builtin_fmaxf(rm,0.f); mhat+=dl; \
        _Pragma("unroll") for(int r=0;r<16;++r){C0[r]-=dl;C1[r]-=dl;} \
        nm=-mhat; \
        const float f=__builtin_amdgcn_exp2f(-dl); l_reg*=f; if(hi==0)wsf[r32]=f; resc=true; } } \
    SBAR(); \
    GAPB(o[0]=__builtin_amdgcn_mfma_f32_32x32x16_bf16(PAF(0),VFR(0),o[0],0,0,0), C0,0); \
    GAPB(o[1]=__builtin_amdgcn_mfma_f32_32x32x16_bf16(PAF(0),VFR(4),o[1],0,0,0), C0,4); \
    KRD(GL,0); GAPB(o[0]=__builtin_amdgcn_mfma_f32_32x32x16_bf16(PAF(1),VFR(1),o[0],0,0,0), C0,8); \
    KRD(GL,1); GAPB(o[1]=__builtin_amdgcn_mfma_f32_32x32x16_bf16(PAF(1),VFR(5),o[1],0,0,0), C0,12); \
    KRD(GL,2); GAPB(o[0]=__builtin_amdgcn_mfma_f32_32x32x16_bf16(PAF(2),VFR(2),o[0],0,0,0), C1,0); \
    KRD(GL,3); GAPB(o[1]=__builtin_amdgcn_mfma_f32_32x32x16_bf16(PAF(2),VFR(6),o[1],0,0,0), C1,4); \
    GAPB(o[0]=__builtin_amdgcn_mfma_f32_32x32x16_bf16(PAF(3),VFR(3),o[0],0,0,0), C1,8); \
    GAPB(o[1]=__builtin_amdgcn_mfma_f32_32x32x16_bf16(PAF(3),VFR(7),o[1],0,0,0), C1,12); \
    }while(0)
  int t=1;
  #undef CMASK
  #define CMASK(P0,P1,t) do{}while(0)
  for(;t+5<NT;t+=2){
    STEP(pB0,pB1,pA0,pA1,t,true,true,true);     WAIT_BAR(2); RESC(); ROT();
    STEP(pA0,pA1,pB0,pB1,t+1,true,true,true);   WAIT_BAR(2); RESC(); ROT();
  }
  #undef CMASK
  #define CMASK(P0,P1,t) do{ if(MODE==0){int jb_=(t)-(NT-4); if(jb_>=0)cmask(P0,P1,jb_,qrel,hi);} }while(0)
  #define ENDW(tt) do{ if((tt)+3<NT){WAIT_BAR(2);} else if((tt)+2<NT){WAIT_BAR(1);} else {WAIT_BAR(0);} }while(0)
  for(;t+1<NT;t+=2){
    STEP(pB0,pB1,pA0,pA1,t,(t+3<NT),(t+1<NT),(t+1<NT));       ENDW(t);   RESC(); ROT();
    STEP(pA0,pA1,pB0,pB1,t+1,(t+4<NT),(t+2<NT),(t+2<NT));     ENDW(t+1); RESC(); ROT();
  }
  STEP(pB0,pB1,pA0,pA1,NT-1,false,false,false); RESC();
  { float sacc=pB0[0]+pB0[1]; _Pragma("unroll") for(int r=2;r<16;++r)sacc+=pB0[r]; _Pragma("unroll") for(int r=0;r<16;++r)sacc+=pB1[r]; l_reg+=sacc;
    pw0=(u32x4){PKW(pB0,0),PKW(pB0,2),PKW(pB0,4),PKW(pB0,6)};pw1=(u32x4){PKW(pB0,8),PKW(pB0,10),PKW(pB0,12),PKW(pB0,14)};pw2=(u32x4){PKW(pB1,0),PKW(pB1,2),PKW(pB1,4),PKW(pB1,6)};pw3=(u32x4){PKW(pB1,8),PKW(pB1,10),PKW(pB1,12),PKW(pB1,14)};
    SBAR(); pv(o,vb0+sl_cur,PAF(0),PAF(1),PAF(2),PAF(3)); }
  #undef PKW
  #undef PAF
  #undef VFR
  #undef PIN
  #undef MX3
  #undef GAPA
  #undef GAPB
  #undef EX
  #undef VRD
  #undef KRD
  #undef STEP
  #undef ENDW
  {auto rr=__builtin_amdgcn_permlane32_swap(__float_as_uint(l_reg),__float_as_uint(l_reg),false,false);l_reg=__uint_as_float(rr[0])+__uint_as_float(rr[1]);}
  if(hi==0)wsf[32+r32]=l_reg;asm volatile("s_waitcnt lgkmcnt(0)":::"memory");
  float rli[16];
  #pragma unroll
  for(int r=0;r<16;++r)rli[r]=__builtin_amdgcn_rcpf(wsf[32+crow(r,hi)]);
  bf16*Ow=O+(rowbase+q0+wid*QBLK)*DM+h*D; const bf16*Gw=G+(rowbase+q0+wid*QBLK)*DM+h*D;
  { bf16*stg=(bf16*)(shm+LDS_OST)+wid*2048;
    #pragma unroll
    for(int r=0;r<16;++r){const int orow=crow(r,hi);
      #pragma unroll
      for(int d0=0;d0<2;++d0)stg[orow*64+d0*32+r32]=__float2bfloat16(o[d0][r]*rli[r]);}
    asm volatile("s_waitcnt lgkmcnt(0)":::"memory");
    #pragma unroll
    for(int i=0;i<4;++i){const int row=i*8+(lane>>3),ch=lane&7; u32x4 v=*(const u32x4*)(stg+row*64+ch*8); const u32x4 g=*reinterpret_cast<const u32x4*>(Gw+(long)row*DM+ch*8);
      _Pragma("unroll") for(int k=0;k<4;++k){ const float vl=__uint_as_float(v[k]<<16),vh=__uint_as_float(v[k]&0xffff0000u),gl=__uint_as_float(g[k]<<16),gh=__uint_as_float(g[k]&0xffff0000u); v[k]=cvtpk_s(vl*gl,vh*gh); }
      ATTN_STORE16(Ow+(long)row*DM+ch*8,v);} }
  asm volatile("s_waitcnt lgkmcnt(0)\n\ts_barrier":::"memory");
  #undef DMA_K
  #undef DMA_V
  #undef CMASK
  #undef CINIT
  #undef START
  #undef RESC
  #undef ROT
}
#undef SBAR
#undef WAIT_BAR
}

constexpr int NWAVES = 8;
#ifndef MK_N_LAUNCHES
#define MK_N_LAUNCHES 1
#endif
constexpr int N_PHASES = 7;
constexpr int N_LAUNCHES = MK_N_LAUNCHES;
constexpr size_t MiB = 1u << 20;
constexpr size_t WS_CTL = 0, CTL_ZERO_BYTES = 64 * 1024;
constexpr size_t WS_MODP = 1 * MiB;
constexpr size_t WS_GATE = 2 * MiB;
constexpr size_t WS_WIN = 4 * MiB;
constexpr size_t WS_WOUT = 14 * MiB;
constexpr size_t WS_FL = 16 * MiB;
constexpr size_t WS_WI = 17 * MiB;
constexpr size_t WS_KI = 18 * MiB;
constexpr size_t WS_RSQ = 22 * MiB;
constexpr size_t WS_MASK = 24 * MiB;
constexpr size_t WS_XN = 32 * MiB;
constexpr size_t WS_Q = 96 * MiB, WS_K = 160 * MiB, WS_V = 224 * MiB, WS_G = 288 * MiB;
constexpr size_t WS_QI = 352 * MiB;
constexpr size_t WS_END = 384 * MiB;
constexpr int CW_BAR = 1024;

constexpr int RING_OFF = 0, RING_BYTES = 131072;
constexpr int UP_OFF = 131072;
constexpr int LDS_BYTES = 163840, LDSCTL_OFF = LDS_BYTES - 512, MISC_OFF = LDSCTL_OFF;
static_assert(attn_body::LDS_BYTES_DSA <= LDSCTL_OFF, "DSA attention scratch fits");

#define GAS __attribute__((address_space(1)))
#define LAS __attribute__((address_space(3)))
typedef unsigned short bf16;
typedef unsigned v4u __attribute__((ext_vector_type(4)));
typedef float f32x4 __attribute__((ext_vector_type(4)));
typedef float f32x16 __attribute__((ext_vector_type(16)));
typedef short bf16x8 __attribute__((ext_vector_type(8)));
typedef GAS unsigned gu32;
typedef GAS unsigned long long gu64;
#define RLX_AGENT __ATOMIC_RELAXED, __HIP_MEMORY_SCOPE_AGENT
#define LDS_WAIT() asm volatile("s_waitcnt lgkmcnt(0)" ::: "memory")
#define VM_WAIT() asm volatile("s_waitcnt vmcnt(0)" ::: "memory")
__device__ __forceinline__ unsigned f2bf(float f) { unsigned u = __builtin_bit_cast(unsigned, f); return (u + 0x7fffu + ((u >> 16) & 1u)) >> 16; }
__device__ __forceinline__ unsigned pk2(float lo, float hi) { return f2bf(lo) | (f2bf(hi) << 16); }
#define XB_TMO      128
#define XB_XCNT(j)  (256  + 64 * (j))
#define XB_XSUB(j)  (1280 + 64 * (j))
#define XB_XGEN(j)  (2304 + 64 * (j))
#define XB_TOP      3328
#define XB_TOPGEN   3392
#define XCD_BAR_WORDS 3456
#define XB_SPIN_CAP (1u << 18)

__device__ __forceinline__ unsigned xb_ld(unsigned* p)              { return __hip_atomic_load(p, __ATOMIC_RELAXED, __HIP_MEMORY_SCOPE_AGENT); }
__device__ __forceinline__ unsigned xb_add(unsigned* p, unsigned v) { return __hip_atomic_fetch_add(p, v, __ATOMIC_RELAXED, __HIP_MEMORY_SCOPE_AGENT); }
__device__ __forceinline__ unsigned xb_xcc_id() { return (unsigned)__builtin_amdgcn_s_getreg((3 << 11) | 20) & 0xFu; }
#define XB_SPIN(cond, bar) do { unsigned _sp = 0; while (cond) { __builtin_amdgcn_s_sleep(1); \
    if ((++_sp & 255u) == 0u) { if (xb_ld(&(bar)[XB_TMO])) break; if (_sp > XB_SPIN_CAP) { atomicAdd(&(bar)[XB_TMO], 1u); break; } } } } while (0)

struct XcdBarrier {
    unsigned* bar; unsigned x;
    volatile LAS unsigned* st;
};

__device__ __forceinline__ XcdBarrier xcd_barrier_post(unsigned* bar, volatile LAS unsigned* st) {
    XcdBarrier b; b.bar = bar; b.x = xb_xcc_id(); b.st = st;
    if (threadIdx.x == 0) (void)xb_add(&bar[XB_XCNT(b.x)], 1u);
    return b;
}
__device__ __forceinline__ void xcd_barrier_complete(unsigned* bar, unsigned x, unsigned& nloc, unsigned& nx) {
    const unsigned G = gridDim.x * gridDim.y * gridDim.z;
    unsigned sum, cnt, mine, sp = 0u;
    for (;;) {
        sum = 0u; cnt = 0u; mine = 0u;
#pragma unroll
        for (unsigned j = 0; j < 16; ++j) { const unsigned c = xb_ld(&bar[XB_XCNT(j)]); sum += c; cnt += (c > 0u) ? 1u : 0u; mine = (j == x) ? c : mine; }
        if (sum == G) break;
        __builtin_amdgcn_s_sleep(1);
        if ((++sp & 255u) == 0u) { if (xb_ld(&bar[XB_TMO])) break; if (sp > XB_SPIN_CAP) { atomicAdd(&bar[XB_TMO], 1u); break; } }
    }
    nloc = mine > 0u ? mine : 1u; nx = cnt > 0u ? cnt : 1u;
}

__device__ __forceinline__ void xcd_barrier(const XcdBarrier& b) {
    asm volatile("s_waitcnt vmcnt(0)" ::: "memory");
    __syncthreads();
    if (threadIdx.x == 0) {
        unsigned* bar = b.bar;
        __builtin_amdgcn_s_waitcnt(0);
        unsigned nloc = b.st[0], nx = b.st[1];
        if (nloc == 0u) { xcd_barrier_complete(bar, b.x, nloc, nx); b.st[0] = nloc; b.st[1] = nx; }
        const unsigned old = xb_add(&bar[XB_XSUB(b.x)], 1u);
        const unsigned gen = old / nloc;
        if (old + 1u == (gen + 1u) * nloc) {
            __builtin_amdgcn_fence(__ATOMIC_RELEASE, "agent");
            asm volatile("s_waitcnt vmcnt(0)" ::: "memory");
            const unsigned og = xb_add(&bar[XB_TOP], 1u);
            const unsigned tg = og / nx;
            if (og + 1u == (tg + 1u) * nx) xb_add(&bar[XB_TOPGEN], 1u);
            else XB_SPIN(xb_ld(&bar[XB_TOPGEN]) == tg, bar);
            __builtin_amdgcn_fence(__ATOMIC_ACQUIRE, "agent");
            xb_add(&bar[XB_XGEN(b.x)], 1u);
            asm volatile("s_waitcnt vmcnt(0)" ::: "memory");
        } else {
            XB_SPIN(xb_ld(&bar[XB_XGEN(b.x)]) == gen, bar);
            __builtin_amdgcn_fence(__ATOMIC_ACQUIRE, "agent");
            asm volatile("s_waitcnt vmcnt(0)" ::: "memory");
        }
    }
    __syncthreads();
}

struct Frame {
    LAS unsigned char* lds;
    volatile LAS unsigned* MISC;
    int tid, lane, wave;
    int vcu, G;
};
__device__ __forceinline__ float wave_sum(float v) {
#pragma unroll
    for (int o = 1; o < 64; o <<= 1) v += __shfl_xor(v, o);
    return v;
}

__device__ __forceinline__ int win_src_col(int n) {
    if (n < 4096) { const int seg = n >> 9, o = n & 511;
        const int base = (seg == 0) ? 0 : (seg == 1) ? 2056 : (seg == 2) ? 512 : (seg == 3) ? 2568 : (seg == 4) ? 1024 : (seg == 5) ? 3080 : (seg == 6) ? 1544 : 4176;
        return base + o; }
    if (n < 4608) return 3592 + (n - 4096);
    if (n < 4616) return 1536 + (n - 4608);
    if (n < 4680) return 4104 + (n - 4616);
    if (n < 4688) return 4168 + (n - 4680);
    return -1;
}
__device__ __forceinline__ void transpose_item(const float* W, int Nsrc, int K, bf16* WT, int n0, int k0, bool permuted, LAS float* scr, int lane) {
    const int n = n0 + (lane & 31); const int sc = permuted ? win_src_col(n) : n;
#pragma unroll 8
    for (int i = 0; i < 32; ++i) { const int kk = 2 * i + (lane >> 5); scr[kk * 33 + (lane & 31)] = (sc >= 0) ? W[(size_t)(k0 + kk) * Nsrc + sc] : 0.f; }
    LDS_WAIT(); asm volatile("" ::: "memory");
    const int c = lane & 7;
#pragma unroll
    for (int j = 0; j < 4; ++j) { const int nn = (lane >> 3) + 8 * j; const LAS float* s = scr + (8 * c) * 33 + nn;
        v4u o; o.x = pk2(s[0 * 33], s[1 * 33]); o.y = pk2(s[2 * 33], s[3 * 33]); o.z = pk2(s[4 * 33], s[5 * 33]); o.w = pk2(s[6 * 33], s[7 * 33]);
        *(GAS v4u*)(WT + (size_t)(n0 + nn) * K + k0 + 8 * c) = o; }
    LDS_WAIT(); asm volatile("" ::: "memory");
}
__device__ __forceinline__ void p0_prologue(Frame& F, const float* c, const float* w_mod, const float* w_in, const float* w_out, float* MODP, bf16* WIN, bf16* WOUT) {
    if (F.vcu < 192) {
        const int j0 = (F.vcu % 48) * 64, sl = F.vcu / 48, k0 = sl * 256;
        LAS float* cact = (LAS float*)(F.lds + RING_OFF);
        LAS float* red = (LAS float*)(F.lds + RING_OFF + 16384);
        for (int idx = F.tid; idx < 4096; idx += 512) { const int kk = idx >> 4, b = idx & 15; const float cv = c[(size_t)b * 1024 + k0 + kk]; cact[kk * 16 + b] = cv / (1.0f + expf(-cv)); }
        __syncthreads();
        float acc[16];
#pragma unroll
        for (int b = 0; b < 16; ++b) acc[b] = 0.f;
#pragma unroll 4
        for (int kk = 0; kk < 32; ++kk) { const int k = 32 * F.wave + kk; const float wv = w_mod[(size_t)(k0 + k) * 3072 + j0 + F.lane];
            const LAS f32x4* cp = (const LAS f32x4*)(cact + k * 16);
#pragma unroll
            for (int q = 0; q < 4; ++q) { const f32x4 cv = cp[q];
#pragma unroll
                for (int e = 0; e < 4; ++e) acc[4 * q + e] += wv * cv[e]; } }
#pragma unroll
        for (int b = 0; b < 16; ++b) red[(F.wave * 16 + b) * 64 + F.lane] = acc[b];
        __syncthreads();
        for (int o = F.tid; o < 1024; o += 512) { const int b = o >> 6, jj = o & 63; float s = 0.f;
#pragma unroll
            for (int w = 0; w < 8; ++w) s += red[(w * 16 + b) * 64 + jj];
            MODP[(size_t)(sl * 16 + b) * 3072 + j0 + jj] = s; }
        __syncthreads();
    }
    LAS float* scr = (LAS float*)(F.lds + RING_OFF + F.wave * 16384);
    const int gw = F.vcu * NWAVES + F.wave, NGW = F.G * NWAVES;
    constexpr int NB_IN = N_INP / 32, I_IN = 16 * NB_IN, I_OUT = 16 * 32;
    for (int it = gw; it < I_IN + I_OUT; it += NGW) {
        if (it < I_IN) { const int kb = it / NB_IN, nb = it % NB_IN; transpose_item(w_in, N_IN, 1024, WIN, 32 * nb, 64 * kb, true, scr, F.lane); }
        else { const int r = it - I_IN, kb = r / 32, nb = r % 32; transpose_item(w_out, 1024, 1024, WOUT, 32 * nb, 64 * kb, false, scr, F.lane); }
    }
}

__device__ __forceinline__ void p1_norm(Frame& F, const float* x, const float* b_mod, const float* gain, const float* MODP, float* GATE, bf16* XN) {
    const int g = blockIdx.x, b = g >> 4;
    LAS float* A_l = (LAS float*)(F.lds + UP_OFF); LAS float* S_l = A_l + 1024;
    for (int k = F.tid; k < 1024; k += 512) {
        float sh = b_mod[k], sc = b_mod[1024 + k], gt = b_mod[2048 + k];
#pragma unroll
        for (int s = 0; s < 4; ++s) { const float* mp = MODP + (size_t)(s * 16 + b) * 3072; sh += mp[k]; sc += mp[1024 + k]; gt += mp[2048 + k]; }
        A_l[k] = gain[k] * (1.0f + sc); S_l[k] = sh;
        if ((g & 15) == 0) GATE[(size_t)b * 1024 + k] = gt;
    }
    __syncthreads();
    for (int r = F.wave; r < 128; r += NWAVES) { const size_t row = (size_t)g * 128 + r;
        const GAS f32x4* xr = (const GAS f32x4*)(x + row * 1024) + F.lane;
        f32x4 v[4]; float ss = 0.f;
#pragma unroll
        for (int j = 0; j < 4; ++j) { v[j] = xr[64 * j]; ss += (v[j].x * v[j].x + v[j].y * v[j].y) + (v[j].z * v[j].z + v[j].w * v[j].w); }
        const float rinv = 1.0f / sqrtf(wave_sum(ss) * (1.0f / 1024.0f) + RMS_EPS);
        GAS unsigned long long* o8 = (GAS unsigned long long*)(XN + row * 1024) + F.lane;
#pragma unroll
        for (int j = 0; j < 4; ++j) { const f32x4 a = *(const LAS f32x4*)(A_l + 4 * F.lane + 256 * j), s = *(const LAS f32x4*)(S_l + 4 * F.lane + 256 * j);
            const f32x4 o = v[j] * rinv * a + s;
            o8[64 * j] = (unsigned long long)pk2(o.x, o.y) | ((unsigned long long)pk2(o.z, o.w) << 32); }
    }
}

__device__ __forceinline__ void fox_bias_table(Frame& F, const float* FL, int b, int h) {
    LAS float* kbl = (LAS float*)(F.lds + UP_OFF); LAS float* wtot = kbl + SEQ;
    const int s0 = 4 * F.tid; float p[4];
#pragma unroll
    for (int j = 0; j < 4; ++j) p[j] = FL[((size_t)b * SEQ + s0 + j) * 8 + h];
    p[1] += p[0]; p[2] += p[1]; p[3] += p[2];
    float sc = p[3];
#pragma unroll
    for (int o = 1; o < 64; o <<= 1) { const float t = __shfl_up(sc, o); if (F.lane >= o) sc += t; }
    if (F.lane == 63) wtot[F.wave] = sc;
    __syncthreads();
    float off = sc - p[3];
    for (int w = 0; w < F.wave; ++w) off += wtot[w];
#pragma unroll
    for (int j = 0; j < 4; ++j) kbl[s0 + j] = -(off + p[j]);
    __syncthreads();
}

template <int NI> __device__ __forceinline__ unsigned long long select_row(const LAS unsigned char* krow, int qsw, int NT, int lane) {
    int kreg[NI];
#pragma unroll
    for (int i = 0; i < NI; ++i) { const int kv = 64 * i + lane; int v = -32768; if (i < NT) v = *(const LAS short*)(krow + (((kv >> 2) ^ qsw) * 8) + (kv & 3) * 2); kreg[i] = v; }
    int lo = -32767, hi = 32768, chi = 0;
    for (int it = 0; it < 16; ++it) { const int mid = (lo + hi) >> 1; int c = 0;
#pragma unroll
        for (int i = 0; i < NI; ++i) { c += __popcll(__ballot(kreg[i] >= mid)); if ((i & 7) == 7) __builtin_amdgcn_sched_barrier(0); }
        if (c >= 256) lo = mid; else { hi = mid; chi = c; } }
    const int T = lo, need = 256 - chi; int running = 0; unsigned long long myword = 0ull;
#pragma unroll
    for (int i = 0; i < NI; ++i) { const bool eq = (kreg[i] == T); const unsigned long long em = __ballot(eq);
        const int rank = running + (int)__builtin_amdgcn_mbcnt_hi((unsigned)(em >> 32), __builtin_amdgcn_mbcnt_lo((unsigned)em, 0u));
        const bool sel = (kreg[i] > T) || (eq && rank < need); running += __popcll(em);
        const unsigned long long wd = __ballot(sel); if (lane == i) myword = wd; if ((i & 3) == 3) __builtin_amdgcn_sched_barrier(0); }
    return myword;
}
typedef float f32x4m __attribute__((ext_vector_type(4)));
__device__ __forceinline__ void idx_unit(Frame& F, int b, int u, const bf16* QI, const bf16* KI, const float* WI, unsigned long long* MASK) {
    const int lane = F.lane, wid = F.wave, q16 = lane & 15, g = lane >> 4;
    const int q0 = 16 * u, NT = (u >> 2) + 1; const size_t rowbase = (size_t)b * SEQ;
    LAS unsigned char* keys = F.lds + RING_OFF;
    bf16x8 qreg[8][2];
#pragma unroll
    for (int h = 0; h < 8; ++h)
#pragma unroll
        for (int s = 0; s < 2; ++s) qreg[h][s] = *(const bf16x8*)(QI + (rowbase + q0 + q16) * 512 + h * 64 + 32 * s + 8 * g);
    const f32x4 w0 = *(const f32x4*)(WI + (rowbase + q0 + q16) * 8), w1 = *(const f32x4*)(WI + (rowbase + q0 + q16) * 8 + 4);
    const int t_q = q0 + q16;
#pragma unroll 1
    for (int j = wid; j < NT; j += NWAVES) {
        bf16x8 kf[4][2];
#pragma unroll
        for (int blk = 0; blk < 4; ++blk)
#pragma unroll
            for (int s = 0; s < 2; ++s) kf[blk][s] = *(const bf16x8*)(KI + (rowbase + 64 * j + 16 * blk + q16) * 64 + 32 * s + 8 * g);
#pragma unroll
        for (int blk = 0; blk < 4; ++blk) { f32x4m a = (f32x4m){0.f, 0.f, 0.f, 0.f};
#pragma unroll
            for (int h = 0; h < 8; ++h) { f32x4m sc = (f32x4m){0.f, 0.f, 0.f, 0.f};
                sc = __builtin_amdgcn_mfma_f32_16x16x32_bf16(kf[blk][0], qreg[h][0], sc, 0, 0, 0); sc = __builtin_amdgcn_mfma_f32_16x16x32_bf16(kf[blk][1], qreg[h][1], sc, 0, 0, 0);
                const float wh = (h < 4) ? w0[h & 3] : w1[h & 3];
#pragma unroll
                for (int r = 0; r < 4; ++r) a[r] = fmaf(fmaxf(sc[r], 0.f), wh, a[r]); }
            const int kvb = 64 * j + 16 * blk + 4 * g; unsigned kk[4];
#pragma unroll
            for (int r = 0; r < 4; ++r) { const _Float16 hf = (_Float16)a[r]; short bits = __builtin_bit_cast(short, hf); short key = (bits < 0) ? (short)(bits ^ 0x7fff) : bits;
                if (kvb + r > t_q) key = (short)-32768; kk[r] = (unsigned)(unsigned short)key; }
            const int gidx = 16 * j + 4 * blk + g;
            typedef unsigned u32x2v __attribute__((ext_vector_type(2)));
            *(LAS u32x2v*)(keys + q16 * 4096 + ((gidx ^ q16) * 8)) = (u32x2v){kk[0] | (kk[1] << 16), kk[2] | (kk[3] << 16)}; }
    }
    __syncthreads();
#pragma unroll 1
    for (int qi = 0; qi < 2; ++qi) { const int q = 2 * wid + qi, t = q0 + q; unsigned long long myword;
        if (t < 256) { const int lo = 64 * lane; myword = (t >= lo + 63) ? ~0ull : (t < lo) ? 0ull : ((2ull << (t - lo)) - 1ull); }
        else { const LAS unsigned char* krow = keys + q * 4096; const int qsw = q & 15;
            if (NT <= 8) myword = select_row<8>(krow, qsw, NT, lane); else if (NT <= 16) myword = select_row<16>(krow, qsw, NT, lane);
            else if (NT <= 24) myword = select_row<24>(krow, qsw, NT, lane); else myword = select_row<32>(krow, qsw, NT, lane); }
        if (lane < 32) MASK[(rowbase + t) * 32 + lane] = myword; }
    __syncthreads();
}

__device__ __forceinline__ void p6_final(Frame& F, float* out, const float* RSQ, const float* fgain) {
    const int gw = F.vcu * NWAVES + F.wave, NGW = F.G * NWAVES;
    f32x4 gv[4];
#pragma unroll
    for (int j = 0; j < 4; ++j) gv[j] = *(const f32x4*)(fgain + 4 * F.lane + 256 * j);
    for (int row = gw; row < M_TOK; row += NGW) {
        const float p = (F.lane < 16) ? RSQ[(size_t)row * 16 + F.lane] : 0.f;
        const float rinv = 1.0f / sqrtf(wave_sum(p) * (1.0f / 1024.0f) + RMS_EPS);
        GAS f32x4* zr = (GAS f32x4*)(out + (size_t)row * 1024) + F.lane;
        f32x4 v[4];
#pragma unroll
        for (int j = 0; j < 4; ++j) v[j] = zr[64 * j];
#pragma unroll
        for (int j = 0; j < 4; ++j) zr[64 * j] = v[j] * rinv * gv[j];
    }
}

struct Args { const float* in[9]; float* out; unsigned char* ws; int ph_lo, ph_hi; };
static_assert(sizeof(Args) == 9 * 8 + 8 + 8 + 8, "Args has no padding bytes");
__global__ void __launch_bounds__(NWAVES * 64, 2) mega_fwd(Args args) {
    extern __shared__ __attribute__((aligned(16))) unsigned char lds[];
    Frame F;
    F.lds = (LAS unsigned char*)lds;
    F.MISC = (volatile LAS unsigned*)(F.lds + MISC_OFF);
    F.tid = threadIdx.x; F.lane = F.tid & 63; F.wave = __builtin_amdgcn_readfirstlane(F.tid >> 6);
    F.G = gridDim.x; { const int bx = blockIdx.x; F.vcu = (F.G % 8 == 0) ? (bx % 8) * (F.G / 8) + bx / 8 : bx; }
    unsigned char* ws = args.ws;
    gu32* ctl = (gu32*)(ws + WS_CTL);
    const float* x = args.in[0]; const float* c = args.in[1]; const float* w_mod = args.in[2]; const float* b_mod = args.in[3]; const float* gain = args.in[4];
    const float* w_in = args.in[5]; const float* b_forget = args.in[6]; const float* w_out = args.in[7]; const float* fgain = args.in[8];
    float* MODP = (float*)(ws + WS_MODP); float* GATE = (float*)(ws + WS_GATE); bf16* WIN = (bf16*)(ws + WS_WIN); bf16* WOUT = (bf16*)(ws + WS_WOUT);
    float* FL = (float*)(ws + WS_FL); float* WI = (float*)(ws + WS_WI); bf16* KI = (bf16*)(ws + WS_KI); float* RSQ = (float*)(ws + WS_RSQ);
    unsigned long long* MASK = (unsigned long long*)(ws + WS_MASK); bf16* XN = (bf16*)(ws + WS_XN);
    bf16* QB = (bf16*)(ws + WS_Q); bf16* KB = (bf16*)(ws + WS_K); bf16* VB = (bf16*)(ws + WS_V); bf16* GB = (bf16*)(ws + WS_G); bf16* QIB = (bf16*)(ws + WS_QI);
    for (int u = F.tid; u < (LDS_BYTES - LDSCTL_OFF) / 4; u += NWAVES * 64) ((LAS unsigned*)(F.lds + LDSCTL_OFF))[u] = 0u;
    __syncthreads();
    XcdBarrier bar; bar.bar = (unsigned*)(ctl + CW_BAR); bar.x = 0; bar.st = nullptr;
    if (N_LAUNCHES == 1) bar = xcd_barrier_post((unsigned*)(ctl + CW_BAR), F.MISC + 8);
    const int lo = args.ph_lo, hi = args.ph_hi;
#define IN(k) (lo <= (k) && (k) < hi)
#define SEAM(k) do { if (IN(k) && IN((k) + 1)) xcd_barrier(bar); } while (0)

    if (IN(0)) { p0_prologue(F, c, w_mod, w_in, w_out, MODP, WIN, WOUT); } SEAM(0);
    if (IN(1)) { p1_norm(F, x, b_mod, gain, MODP, GATE, XN); } SEAM(1);
    if (IN(2)) {
        pg8::Gemm g{XN, WIN, M_TOK, N_INP, 1024}; pg8::StaticOrder S; S.init(M_TOK, N_INP, F.G, (int)blockIdx.x);
        pg8::EpiIn E{QB, KB, VB, GB, QIB, KI, FL, WI, b_forget};
        pg8::gemm_phase<pg8::EpiIn, pg8::StaticOrder, true, true>(F.lds + RING_OFF, g, S, E);
    } SEAM(2);
    if (IN(3)) {
#ifndef NO_FOX
        { const int bh = F.vcu >> 1, b = bh >> 3, h = bh & 7, sel = F.vcu & 1;
          fox_bias_table(F, FL, b, h);
          const float* kbl = (const float*)(lds + UP_OFF);
#pragma unroll 1
          for (int i = 0; i < 4; ++i) { const int qb = sel ? ((i == 0) ? 1 : (i == 1) ? 6 : (i == 2) ? 2 : 5) : ((i == 0) ? 0 : (i == 1) ? 7 : (i == 2) ? 3 : 4);
              attn_body::attn_unit<8, 0>(b, h, qb, (const attn_body::bf16*)QB, (const attn_body::bf16*)KB, (const attn_body::bf16*)VB, (attn_body::bf16*)QB, (const attn_body::bf16*)GB, (char*)lds + RING_OFF, kbl, 0.f, nullptr); }
          __syncthreads(); }
#endif
#ifndef NO_IDX
        { const int b = F.vcu >> 4, j = F.vcu & 15;
#pragma unroll 1
          for (int i = 0; i < 8; ++i) { const int u = 32 * (i >> 1) + ((i & 1) ? 31 - j : j); idx_unit(F, b, u, QIB, KI, WI, MASK); } }
#endif
    } SEAM(3);
    if (IN(4)) {
#ifndef NO_DSA
        const int bh = F.vcu >> 1, b = bh >> 3, hh = bh & 7, sel = F.vcu & 1;
        const float slope2 = exp2f(-(float)(hh + 1)) * LOG2E;
        const unsigned long long* Mb = MASK + (size_t)b * SEQ * 32;
#pragma unroll 1
        for (int i = 0; i < 4; ++i) { const int qb = sel ? ((i == 0) ? 1 : (i == 1) ? 6 : (i == 2) ? 2 : 5) : ((i == 0) ? 0 : (i == 1) ? 7 : (i == 2) ? 3 : 4);
            attn_body::attn_unit<8, 1>(b, 8 + hh, qb, (const attn_body::bf16*)QB, (const attn_body::bf16*)KB, (const attn_body::bf16*)VB, (attn_body::bf16*)QB, (const attn_body::bf16*)GB, (char*)lds + RING_OFF, nullptr, slope2, Mb); }
        __syncthreads();
#endif
    } SEAM(4);
    if (IN(5)) {
        pg8::Gemm g{QB, WOUT, M_TOK, 1024, 1024}; pg8::StaticOrder S; S.init(M_TOK, 1024, F.G, (int)blockIdx.x);
        pg8::EpiOut E{x, args.out, GATE, RSQ};
        pg8::gemm_phase<pg8::EpiOut, pg8::StaticOrder, true, true>(F.lds + RING_OFF, g, S, E);
    } SEAM(5);
    if (IN(6)) { p6_final(F, args.out, RSQ, fgain); }
#undef IN
#undef SEAM
}

extern "C" void kernel_launch(void* const* d_in, const int* in_sizes, int n_in, void* d_out, int out_size, void* d_ws, size_t ws_size, hipStream_t stream) {
    static int grid = 0;
    if (grid == 0) {
        if (n_in != 9 || in_sizes[0] != M_TOK * DMODEL || out_size != M_TOK * DMODEL || ws_size < WS_END) { fprintf(stderr, "kernel_launch: unexpected shapes (n_in %d, in0 %d, out %d, ws %zu); nothing launched\n", n_in, n_in > 0 ? in_sizes[0] : -1, out_size, ws_size); grid = -1; return; }
        int dev = 0, cus = 0, per_cu = 0;
        if (hipGetDevice(&dev) != hipSuccess || hipDeviceGetAttribute(&cus, hipDeviceAttributeMultiprocessorCount, dev) != hipSuccess) { grid = -1; return; }
        if (hipFuncSetAttribute((const void*)mega_fwd, hipFuncAttributeMaxDynamicSharedMemorySize, LDS_BYTES) != hipSuccess) { fprintf(stderr, "kernel_launch: hipFuncSetAttribute failed\n"); grid = -1; return; }
        if (hipOccupancyMaxActiveBlocksPerMultiprocessor(&per_cu, (const void*)mega_fwd, NWAVES * 64, LDS_BYTES) != hipSuccess || per_cu < 1)
            fprintf(stderr, "kernel_launch: note: occupancy query reports %d workgroups per CU\n", per_cu);
        (void)hipGetLastError();
        grid = cus;
        if (grid != 256) fprintf(stderr, "kernel_launch: %d CUs; the static unit orders assume 256\n", grid);
    }
    if (grid < 0) return;
    if (hipMemsetAsync((char*)d_ws + WS_CTL, 0, CTL_ZERO_BYTES, stream) != hipSuccess) { fprintf(stderr, "kernel_launch: memset failed\n"); return; }
    Args a{};
    for (int i = 0; i < 9; ++i) a.in[i] = (const float*)d_in[i];
    a.out = (float*)d_out; a.ws = (unsigned char*)d_ws;
    if (N_LAUNCHES == 1) { a.ph_lo = 0; a.ph_hi = N_PHASES; hipLaunchKernelGGL(mega_fwd, dim3(grid), dim3(NWAVES * 64), LDS_BYTES, stream, a); }
    else { for (int p = 0; p < N_PHASES; ++p) { a.ph_lo = p; a.ph_hi = p + 1; hipLaunchKernelGGL(mega_fwd, dim3(grid), dim3(NWAVES * 64), LDS_BYTES, stream, a); } }
    const hipError_t le = hipPeekAtLastError();
    if (le != hipSuccess) fprintf(stderr, "kernel_launch: launch failed: %s\n", hipGetErrorName(le));
}
```

```cpp
#include <hip/hip_runtime.h>
#include <hip/hip_bf16.h>
#include <cstdio>
#include <cstdint>
#include <cmath>

constexpr int BATCH = 16, SEQ = 2048, DMODEL = 1024, M_TOK = BATCH * SEQ;
constexpr int N_IN = 4688, N_INP = 4864;
constexpr float RMS_EPS = 1e-6f;
constexpr float LOG2E = 1.4426950408889634f;
constexpr float QSCALE = 0.125f * LOG2E;

namespace pg8 {
#define PG8_LAS __attribute__((address_space(3)))
typedef unsigned short bf16_t;
typedef short bf16x8 __attribute__((ext_vector_type(8)));
typedef float f32x4 __attribute__((ext_vector_type(4)));
typedef unsigned u32x4 __attribute__((ext_vector_type(4)));
constexpr int BM = 256, BK = 64, HALF = 128, HTB = HALF * BK * 2  , STAGE_BYTES = 8 * HTB, NXCD = 8, WGM = 8;

__host__ __device__ __forceinline__ int lds_byte(int r, int c) { const int st = (r >> 4) * 2 + (c >> 5), rr = r & 15, cc = c & 31, ob = rr * 64 + cc * 2; return st * 1024 + (ob ^ (((ob >> 9) & 1) << 5)); }
__host__ __device__ __forceinline__ void stage_rc(int b, int& R, int& C) { const int st = b / 1024, sb = b % 1024, swz = sb ^ (((sb >> 9) & 1) << 5); R = (st >> 1) * 16 + swz / 64; C = (st & 1) * 32 + (swz % 64) / 2; }
__host__ __device__ __forceinline__ int perm32(int rho) { const int n = rho >> 4, i = rho & 15; return 8 * (i >> 2) + 4 * n + (i & 3); }

struct Unit { int pm, pn; };
struct Gemm { const bf16_t* A; const bf16_t* Bt; int M, N, K; };

struct StaticOrder {
    int nM, nN, nwg, G, c;
    __host__ __device__ void init(int M, int N, int G_, int c_) { nM = M / BM; nN = N / BM; nwg = nM * nN; G = G_; c = c_; }
    __host__ __device__ bool next(int i, Unit& u) const {
        const long L = (long)i * G + c; if (L >= nwg) return false;
        int wgid = (int)L; { const int q = nwg / NXCD, r = nwg % NXCD, xcd = wgid % NXCD, off = wgid / NXCD; wgid = (xcd < r ? xcd * (q + 1) : r * (q + 1) + (xcd - r) * q) + off; }
        const int nig = WGM * nN, gid = wgid / nig, fm = gid * WGM, gsz = (nM - fm) < WGM ? (nM - fm) : WGM;
        u.pm = fm + ((wgid % nig) % gsz); u.pn = (wgid % nig) / gsz; return true;
    }
    __device__ __forceinline__ void a_ready(const Unit&) const {}
    __device__ __forceinline__ void done(const Unit&) const {}
};


__device__ __forceinline__ unsigned cvt_pk_bf16(float lo, float hi) { unsigned r; asm volatile("v_cvt_pk_bf16_f32 %0, %1, %2" : "=v"(r) : "v"(lo), "v"(hi)); return r; }
__device__ __forceinline__ unsigned cvt_pk_f16(float lo, float hi) { typedef float f2_t __attribute__((ext_vector_type(2))); typedef _Float16 h2_t __attribute__((ext_vector_type(2)));
    const f2_t v = {lo, hi}; const h2_t h = __builtin_convertvector(v, h2_t); return __builtin_bit_cast(unsigned, h); }
__device__ __forceinline__ float silu_f(float v) { return v * __builtin_amdgcn_rcpf(1.0f + __builtin_amdgcn_exp2f(-1.4426950408889634f * v)); }
__device__ __forceinline__ float logsig2_f(float x) {
    const float ls = fminf(x, 0.f) - log1pf(expf(-fabsf(x))); return ls * 1.4426950408889634f; }

struct EpiIn {
    static constexpr bool PERM = true, AFTER_DRAIN = false;
    bf16_t *Q, *K, *V, *G, *QI, *KI; float *FL, *WI; const float* bforget;
    __device__ __forceinline__ void operator()(const f32x4 (&acc)[2][2][4][2], const Unit& u, int wr, int wc, int fr, int fq) const {
        const int row0 = u.pm * BM + wr * 64 + fr; const int pn = u.pn;
        if (pn < 18) {
            bf16_t* base; int ldc, colt; int mode = 0;
            if (pn < 16) { const int t = pn >> 2; base = (t == 0) ? Q : (t == 1) ? K : (t == 2) ? V : G; ldc = 1024; colt = (pn & 3) * 256; mode = (t == 0) ? 1 : (t == 3) ? 2 : 0; }
            else { base = QI; ldc = 512; colt = (pn - 16) * 256; }
            const int col0 = colt + wc * 32 + 8 * fq;
#pragma unroll
            for (int ai = 0; ai < 2; ++ai)
#pragma unroll
                for (int m = 0; m < 4; ++m) { bf16_t* rowp = base + (size_t)(row0 + ai * HALF + m * 16) * ldc + col0;
#pragma unroll
                    for (int bj = 0; bj < 2; ++bj) { f32x4 v0 = acc[ai][bj][m][0], v1 = acc[ai][bj][m][1];
                        if (mode == 1) { v0 = v0 * QSCALE; v1 = v1 * QSCALE; }
                        else if (mode == 2) {
#pragma unroll
                            for (int j = 0; j < 4; ++j) { v0[j] = silu_f(v0[j]); v1[j] = silu_f(v1[j]); } }
                        u32x4 w;
                        if (pn >= 16) { w.x = cvt_pk_f16(v0[0], v0[1]); w.y = cvt_pk_f16(v0[2], v0[3]); w.z = cvt_pk_f16(v1[0], v1[1]); w.w = cvt_pk_f16(v1[2], v1[3]); }
                        else { w.x = cvt_pk_bf16(v0[0], v0[1]); w.y = cvt_pk_bf16(v0[2], v0[3]); w.z = cvt_pk_bf16(v1[0], v1[1]); w.w = cvt_pk_bf16(v1[2], v1[3]); }
                        *(u32x4*)(rowp + bj * HALF) = w; } }
        } else {
            const int c8 = wc * 32 + 8 * fq;
            if (c8 < 80) {
                f32x4 bf0 = (f32x4){0.f, 0.f, 0.f, 0.f}, bf1 = bf0;
                if (c8 == 0) { bf0 = *(const f32x4*)(bforget); bf1 = *(const f32x4*)(bforget + 4); }
#pragma unroll
                for (int ai = 0; ai < 2; ++ai)
#pragma unroll
                    for (int m = 0; m < 4; ++m) { const size_t row = (size_t)(row0 + ai * HALF + m * 16); f32x4 v0 = acc[ai][0][m][0], v1 = acc[ai][0][m][1];
                        if (c8 == 0) {
#pragma unroll
                            for (int j = 0; j < 4; ++j) { v0[j] = logsig2_f(v0[j] + bf0[j]); v1[j] = logsig2_f(v1[j] + bf1[j]); }
                            *(f32x4*)(FL + row * 8) = v0; *(f32x4*)(FL + row * 8 + 4) = v1;
                        } else if (c8 == 72) { *(f32x4*)(WI + row * 8) = v0; *(f32x4*)(WI + row * 8 + 4) = v1;
                        } else { u32x4 w; w.x = cvt_pk_f16(v0[0], v0[1]); w.y = cvt_pk_f16(v0[2], v0[3]); w.z = cvt_pk_f16(v1[0], v1[1]); w.w = cvt_pk_f16(v1[2], v1[3]);
                            *(u32x4*)(KI + row * 64 + (c8 - 8)) = w; } }
            }
        }
    }
};

struct EpiOut {
    static constexpr bool PERM = false, AFTER_DRAIN = false;
    const float* x; float* out; const float* gate; float* rowsq;
    __device__ __forceinline__ void operator()(const f32x4 (&acc)[2][2][4][2], const Unit& u, int wr, int wc, int fr, int fq) const {
        const int b = u.pm >> 3;
        const int col0 = u.pn * BM + wc * 32 + 4 * fq;
        f32x4 gv[2][2];
#pragma unroll
        for (int bj = 0; bj < 2; ++bj)
#pragma unroll
            for (int n = 0; n < 2; ++n) gv[bj][n] = *(const f32x4*)(gate + (size_t)b * 1024 + col0 + bj * HALF + n * 16);
#pragma unroll
        for (int ai = 0; ai < 2; ++ai)
#pragma unroll
            for (int m = 0; m < 4; ++m) { const int row = u.pm * BM + ai * HALF + wr * 64 + m * 16 + fr; const size_t off = (size_t)row * 1024 + col0; float sq = 0.f;
#pragma unroll
                for (int bj = 0; bj < 2; ++bj)
#pragma unroll
                    for (int n = 0; n < 2; ++n) { const f32x4 xv = *(const f32x4*)(x + off + bj * HALF + n * 16); const f32x4 z = xv + gv[bj][n] * acc[ai][bj][m][n];
                        *(f32x4*)(out + off + bj * HALF + n * 16) = z; sq += (z[0] * z[0] + z[1] * z[1]) + (z[2] * z[2] + z[3] * z[3]); }
                sq += __shfl_xor(sq, 16); sq += __shfl_xor(sq, 32);
                if (fq == 0) rowsq[(size_t)row * 16 + u.pn * 4 + wc] = sq;
                if (m & 1) asm volatile("" ::: "memory"); }
    }
};

template <class Epi, class Sched, bool ALIGN_EPI = false, bool SP2 = false>
__device__ __forceinline__ void gemm_phase(PG8_LAS unsigned char* lds, const Gemm g, const Sched& S, const Epi& E) {
    const int tid = threadIdx.x, wid = __builtin_amdgcn_readfirstlane(tid >> 6), lane = tid & 63, wr = wid >> 2, wc = wid & 3, fr = lane & 15, fq = lane >> 4;
    const int K = g.K, nt = K / BK;
    unsigned voffA[2], voffB[2];
#pragma unroll
    for (int i = 0; i < 2; ++i) { int R, C; stage_rc(tid * 16 + i * 8192, R, C); const int Rb = Epi::PERM ? ((R & ~31) + perm32(R & 31)) : R;
        voffA[i] = (unsigned)(R * K + C) * 2u; voffB[i] = (unsigned)(Rb * K + C) * 2u; }
    const size_t kstep = (size_t)(BK * 2);
    const size_t hstep = (size_t)HALF * K * 2;
    const size_t tstep = 2 * hstep;
    const unsigned ldsw = (unsigned)wid * 1024u;
    const int aoff = lds_byte(wr * 64 + fr, fq * 8), boff = lds_byte(wc * 32 + fr, fq * 8);
#define PG8_SA(b, h) (((b) * 2 + (h)) * HTB)
#define PG8_SB(b, h) ((4 + (b) * 2 + (h)) * HTB)
#define PG8_STAGE(bufoff, gbase, voff) do { _Pragma("unroll") for (int _i = 0; _i < 2; ++_i) \
        __builtin_amdgcn_global_load_lds((const unsigned*)((const char*)(gbase) + (voff)[_i]), (PG8_LAS unsigned*)(lds + (bufoff) + ldsw + _i * 8192), 16, 0, 0); } while (0)
#define PG8_LDA(dst, b, h) do { _Pragma("unroll") for (int m = 0; m < 4; ++m) _Pragma("unroll") for (int k = 0; k < 2; ++k) dst[m][k] = *(const PG8_LAS bf16x8*)(lds + PG8_SA(b, h) + aoff + m * 2048 + k * 1024); } while (0)
#define PG8_LDB(dst, b, h) do { _Pragma("unroll") for (int n = 0; n < 2; ++n) _Pragma("unroll") for (int k = 0; k < 2; ++k) dst[n][k] = *(const PG8_LAS bf16x8*)(lds + PG8_SB(b, h) + boff + n * 2048 + k * 1024); } while (0)
#define PG8_MMA(ai, bj, At, Bt) do { __builtin_amdgcn_s_setprio(1); _Pragma("unroll") for (int m = 0; m < 4; ++m) _Pragma("unroll") for (int n = 0; n < 2; ++n) _Pragma("unroll") for (int k = 0; k < 2; ++k) \
        acc[ai][bj][m][n] = __builtin_amdgcn_mfma_f32_16x16x32_bf16(Bt[n][k], At[m][k], acc[ai][bj][m][n], 0, 0, 0); __builtin_amdgcn_s_setprio(0); } while (0)
#define PG8_WAIT_V(n) asm volatile("s_waitcnt vmcnt(" #n ")" ::: "memory")
#define PG8_WAIT_L(n) asm volatile("s_waitcnt lgkmcnt(" #n ")" ::: "memory")
#define PG8_BAR __builtin_amdgcn_s_barrier()
#define PG8_SCHED __builtin_amdgcn_sched_barrier(0)
    Unit cur, nxt; int ui = 0;
    if (!S.next(0, cur)) return;
    f32x4 acc[2][2][4][2];
#pragma unroll
    for (int a = 0; a < 2; ++a)
#pragma unroll
        for (int b = 0; b < 2; ++b)
#pragma unroll
            for (int m = 0; m < 4; ++m)
#pragma unroll
                for (int n = 0; n < 2; ++n) acc[a][b][m][n] = (f32x4){0.f, 0.f, 0.f, 0.f};
    bf16x8 At[4][2], B0[2][2], B1[2][2];
    const char* cA = (const char*)g.A + (size_t)cur.pm * tstep; const char* cB = (const char*)g.Bt + (size_t)cur.pn * tstep;
    S.a_ready(cur);
    if constexpr (SP2) {
        PG8_STAGE(PG8_SB(0, 0), cB, voffB); PG8_STAGE(PG8_SB(0, 1), cB + hstep, voffB); PG8_STAGE(PG8_SA(0, 0), cA, voffA); PG8_STAGE(PG8_SA(0, 1), cA + hstep, voffA);
        if (wr == 1) PG8_BAR;
        PG8_WAIT_V(2); PG8_BAR;
        PG8_STAGE(PG8_SB(1, 0), cB + kstep, voffB); PG8_STAGE(PG8_SA(1, 0), cA + kstep, voffA); PG8_STAGE(PG8_SB(1, 1), cB + hstep + kstep, voffB);
        PG8_WAIT_V(6); PG8_BAR;
    } else {
        PG8_STAGE(PG8_SB(0, 0), cB, voffB); PG8_STAGE(PG8_SA(0, 0), cA, voffA); PG8_STAGE(PG8_SB(0, 1), cB + hstep, voffB); PG8_STAGE(PG8_SA(0, 1), cA + hstep, voffA);
        if (wr == 1) PG8_BAR;
        PG8_WAIT_V(4); PG8_BAR;
        PG8_STAGE(PG8_SB(1, 0), cB + kstep, voffB); PG8_STAGE(PG8_SA(1, 0), cA + kstep, voffA); PG8_STAGE(PG8_SB(1, 1), cB + hstep + kstep, voffB);
        PG8_WAIT_V(6); PG8_BAR;
    }
    for (;;) {
        const bool has_next = S.next(ui + 1, nxt);
        const char* nA = has_next ? (const char*)g.A + (size_t)nxt.pm * tstep : cA; const char* nB = has_next ? (const char*)g.Bt + (size_t)nxt.pn * tstep : cB;
        for (int t = 0; t < nt; t += 2) {
            const bool last = (t == nt - 2);
            const char* a1 = cA + (size_t)(t + 1) * kstep;
            const char* a2 = last ? nA : cA + (size_t)(t + 2) * kstep; const char* b2 = last ? nB : cB + (size_t)(t + 2) * kstep;
            const char* a3 = a2 + kstep; const char* b3 = b2 + kstep;
            if (last && has_next) S.a_ready(nxt);
            if constexpr (SP2) {
            PG8_LDB(B0, 0, 0); PG8_LDB(B1, 0, 1); PG8_SCHED; PG8_LDA(At, 0, 0); PG8_STAGE(PG8_SA(1, 1), a1 + hstep, voffA);
            PG8_WAIT_V(8); PG8_WAIT_L(0); PG8_BAR; PG8_MMA(0, 0, At, B0); PG8_MMA(0, 1, At, B1); PG8_BAR; PG8_SCHED;
            PG8_LDA(At, 0, 1); PG8_STAGE(PG8_SB(0, 0), b2, voffB); PG8_STAGE(PG8_SB(0, 1), b2 + hstep, voffB); PG8_STAGE(PG8_SA(0, 0), a2, voffA);
            PG8_WAIT_V(8); PG8_WAIT_L(0); PG8_BAR; PG8_MMA(1, 0, At, B0); PG8_MMA(1, 1, At, B1); PG8_BAR; PG8_SCHED;
            PG8_LDB(B0, 1, 0); PG8_LDB(B1, 1, 1); PG8_SCHED; PG8_LDA(At, 1, 0); PG8_STAGE(PG8_SA(0, 1), a2 + hstep, voffA);
            PG8_WAIT_V(8); PG8_WAIT_L(0); PG8_BAR; PG8_MMA(0, 0, At, B0); PG8_MMA(0, 1, At, B1); PG8_BAR; PG8_SCHED;
            PG8_LDA(At, 1, 1); PG8_STAGE(PG8_SB(1, 0), b3, voffB); PG8_STAGE(PG8_SB(1, 1), b3 + hstep, voffB); PG8_STAGE(PG8_SA(1, 0), a3, voffA);
            PG8_WAIT_V(8); PG8_WAIT_L(0); PG8_BAR; PG8_MMA(1, 0, At, B0); PG8_MMA(1, 1, At, B1); PG8_BAR; PG8_SCHED;
            } else {
            PG8_LDB(B0, 0, 0); PG8_SCHED; PG8_LDA(At, 0, 0); PG8_STAGE(PG8_SA(1, 1), a1 + hstep, voffA);
            PG8_WAIT_L(8); PG8_BAR; PG8_WAIT_L(0); PG8_MMA(0, 0, At, B0); PG8_BAR; PG8_SCHED;
            PG8_LDB(B1, 0, 1); PG8_STAGE(PG8_SB(0, 0), b2, voffB);
            PG8_BAR; PG8_WAIT_L(0); PG8_MMA(0, 1, At, B1); PG8_BAR;
            PG8_LDA(At, 0, 1); PG8_STAGE(PG8_SA(0, 0), a2, voffA);
            PG8_BAR; PG8_WAIT_L(0); PG8_MMA(1, 0, At, B0); PG8_BAR; PG8_SCHED;
            PG8_STAGE(PG8_SB(0, 1), b2 + hstep, voffB);
            PG8_WAIT_V(6); PG8_BAR; PG8_MMA(1, 1, At, B1); PG8_BAR;
            PG8_LDB(B0, 1, 0); PG8_SCHED; PG8_LDA(At, 1, 0); PG8_STAGE(PG8_SA(0, 1), a2 + hstep, voffA);
            PG8_WAIT_L(8); PG8_BAR; PG8_WAIT_L(0); PG8_MMA(0, 0, At, B0); PG8_BAR; PG8_SCHED;
            PG8_LDB(B1, 1, 1); PG8_STAGE(PG8_SB(1, 0), b3, voffB);
            PG8_BAR; PG8_WAIT_L(0); PG8_MMA(0, 1, At, B1); PG8_BAR;
            PG8_LDA(At, 1, 1); PG8_STAGE(PG8_SA(1, 0), a3, voffA);
            PG8_BAR; PG8_WAIT_L(0); PG8_MMA(1, 0, At, B0); PG8_BAR; PG8_SCHED;
            PG8_STAGE(PG8_SB(1, 1), b3 + hstep, voffB);
            PG8_WAIT_V(6); PG8_BAR; PG8_MMA(1, 1, At, B1); PG8_BAR;
            }
        }
        if constexpr (ALIGN_EPI) { if (wr == 0) PG8_BAR; }
        if constexpr (!Epi::AFTER_DRAIN) { E(acc, cur, wr, wc, fr, fq); S.done(cur); }
        if (!has_next) break;
#pragma unroll
        for (int a = 0; a < 2; ++a)
#pragma unroll
            for (int b = 0; b < 2; ++b)
#pragma unroll
                for (int m = 0; m < 4; ++m)
#pragma unroll
                    for (int n = 0; n < 2; ++n) acc[a][b][m][n] = (f32x4){0.f, 0.f, 0.f, 0.f};
        cur = nxt; cA = nA; cB = nB; ++ui;
        if constexpr (ALIGN_EPI) { if (wr == 1) PG8_BAR; }
    }
    PG8_WAIT_V(0);
    if constexpr (!ALIGN_EPI) { if (wr == 0) PG8_BAR; }
    PG8_BAR;
    if constexpr (Epi::AFTER_DRAIN) { E.fused(acc, cur, wr, wc, fr, fq, lds, wid, lane); S.done(cur); }
#undef PG8_SA
#undef PG8_SB
#undef PG8_STAGE
#undef PG8_LDA
#undef PG8_LDB
#undef PG8_MMA
#undef PG8_WAIT_V
#undef PG8_WAIT_L
#undef PG8_BAR
#undef PG8_SCHED
}
}
#include <hip/hip_bf16.h>
#include <cmath>
namespace attn_body {
using bf16=__hip_bfloat16;
using bf16x8=__attribute__((ext_vector_type(8)))short;
using s16x4=__attribute__((ext_vector_type(4)))short;
using f32x16=__attribute__((ext_vector_type(16)))float;
using u32x4=__attribute__((ext_vector_type(4)))unsigned;
using f32x4_t=__attribute__((ext_vector_type(4)))float;
constexpr int NHEAD=16,D=64,DM=NHEAD*D; using ::SEQ;
constexpr int NW=8,QBLK=32,QB=QBLK*NW,KVBLK=64,NQB=SEQ/QB;
constexpr int ATTN_PITCH=DM, ATTN_UNIT_ROWS=QB;
__device__ __forceinline__ int crow(int r,int hi){return (r&3)+8*(r>>2)+4*hi;}
#define SBAR() __builtin_amdgcn_sched_barrier(0)
__device__ __forceinline__ void cmask(f32x16&p0,f32x16&p1,int jb,int qrel,int hi){
  const float NEG=-INFINITY; int kb=64*jb+4*hi;
  #pragma unroll
  for(int r=0;r<16;++r){int kv=kb+(r&3)+8*(r>>2); if(kv>qrel)p0[r]=NEG; if(kv+32>qrel)p1[r]=NEG;}
}

constexpr int NSLOT=3, SLOTB=8192;
constexpr int LDS_K=0, LDS_V=NSLOT*SLOTB, LDS_WS=2*NSLOT*SLOTB, LDS_OST=LDS_WS+NW*64*4, LDS_BYTES=LDS_OST+NW*4096, LDS_MASK=LDS_BYTES, MASK_ROW=264, MASK_WAVE=32*MASK_ROW, LDS_BYTES_DSA=LDS_MASK+NW*MASK_WAVE;
constexpr float C2=::QSCALE;
__device__ __forceinline__ void glds16(const void*gsrc,unsigned lds_dst){unsigned keep;
  asm volatile("s_mov_b32 %0, m0\n\ts_mov_b32 m0, %2\n\ts_nop 0\n\tglobal_load_lds_dwordx4 %1, off\n\ts_mov_b32 m0, %0":"=&s"(keep):"v"(gsrc),"s"(lds_dst):"memory");}
__device__ __forceinline__ float max3f(float a,float b,float c){float r;asm("v_max3_f32 %0, %1, %2, %3":"=v"(r):"v"(a),"v"(b),"v"(c));return r;}
__device__ __forceinline__ float max2f(float a,float b){float r;asm("v_max_f32_e32 %0, %1, %2":"=v"(r):"v"(a),"v"(b));return r;}
__device__ __forceinline__ float fadd_s(float a,float b){float r;asm("v_add_f32_e32 %0, %1, %2":"=v"(r):"v"(a),"v"(b));return r;}
__device__ __forceinline__ float fsub_s(float a,float b){float r;asm("v_sub_f32_e32 %0, %1, %2":"=v"(r):"v"(a),"v"(b));return r;}
typedef float f32x2_t __attribute__((ext_vector_type(2))); typedef __bf16 bf16x2_t __attribute__((ext_vector_type(2)));
__device__ __forceinline__ unsigned cvtpk_s(float lo,float hi){f32x2_t v={lo,hi};bf16x2_t b=__builtin_convertvector(v,bf16x2_t);return __builtin_bit_cast(unsigned,b);}
#define WAIT_BAR(N) asm volatile("s_waitcnt vmcnt(" #N ") lgkmcnt(0)\n\ts_barrier":::"memory")

__device__ __forceinline__ void qkt(f32x16&p0,f32x16&p1,const char*Kslot,const bf16x8*qr,int r32,int hi){
  const char*kb=Kslot+hi*1024+r32*16;
  #pragma unroll
  for(int d0=0;d0<4;++d0){
    const bf16x8 b0=*reinterpret_cast<const bf16x8*>(kb+d0*2048);
    const bf16x8 b1=*reinterpret_cast<const bf16x8*>(kb+d0*2048+512);
    p0=__builtin_amdgcn_mfma_f32_32x32x16_bf16(b0,qr[d0],p0,0,0,0);p1=__builtin_amdgcn_mfma_f32_32x32x16_bf16(b1,qr[d0],p1,0,0,0);}
}
typedef __attribute__((address_space(3))) const char* lds_cptr;
typedef short v4i16_t __attribute__((ext_vector_type(4)));
__device__ __forceinline__ void kload8(bf16x8*kf,lds_cptr kp){
  kf[0]=*(const __attribute__((address_space(3))) bf16x8*)(kp);      kf[1]=*(const __attribute__((address_space(3))) bf16x8*)(kp+512);
  kf[2]=*(const __attribute__((address_space(3))) bf16x8*)(kp+2048); kf[3]=*(const __attribute__((address_space(3))) bf16x8*)(kp+2560);
  kf[4]=*(const __attribute__((address_space(3))) bf16x8*)(kp+4096); kf[5]=*(const __attribute__((address_space(3))) bf16x8*)(kp+4608);
  kf[6]=*(const __attribute__((address_space(3))) bf16x8*)(kp+6144); kf[7]=*(const __attribute__((address_space(3))) bf16x8*)(kp+6656);
}
__device__ __forceinline__ void kload2(bf16x8*kf,lds_cptr kp,int j){ kf[2*j]=*(const __attribute__((address_space(3))) bf16x8*)(kp+j*2048); kf[2*j+1]=*(const __attribute__((address_space(3))) bf16x8*)(kp+j*2048+512); }
__device__ __forceinline__ s16x4 vtr(lds_cptr p){ return __builtin_bit_cast(s16x4,__builtin_amdgcn_ds_read_tr16_b64_v4i16((__attribute__((address_space(3))) v4i16_t*)p)); }
__device__ __forceinline__ float rowmax(const f32x16&p0,const f32x16&p1){
  float a=max3f(p0[0],p0[1],p1[0]),b=max3f(p0[2],p0[3],p1[1]);a=max3f(a,p1[2],p1[3]);
  #pragma unroll
  for(int r=4;r<16;r+=4){a=max3f(a,p0[r],p0[r+1]);b=max3f(b,p0[r+2],p0[r+3]);a=max3f(a,p1[r],p1[r+1]);b=max3f(b,p1[r+2],p1[r+3]);}
  const float m=max2f(a,b);
  auto rr=__builtin_amdgcn_permlane32_swap(__float_as_uint(m),__float_as_uint(m),false,false);
  return max2f(__uint_as_float(rr[0]),__uint_as_float(rr[1]));
}
__device__ __forceinline__ void pv(f32x16*o,int vb,bf16x8 pa0,bf16x8 pa1,bf16x8 pa2,bf16x8 pa3){
  #pragma unroll
  for(int d0=0;d0<2;++d0){s16x4 lo[4],hi[4];
    #pragma unroll
    for(int ks=0;ks<4;++ks){
      asm volatile("ds_read_b64_tr_b16 %0,%1 offset:%c2":"=&v"(lo[ks]):"v"(vb),"i"(d0*4096+ks*1024):"memory");
      asm volatile("ds_read_b64_tr_b16 %0,%1 offset:%c2":"=&v"(hi[ks]):"v"(vb),"i"(d0*4096+ks*1024+512):"memory");}
    asm volatile("s_waitcnt lgkmcnt(0)":::"memory");SBAR();
    #define PK(k) (bf16x8){lo[k][0],lo[k][1],lo[k][2],lo[k][3],hi[k][0],hi[k][1],hi[k][2],hi[k][3]}
    o[d0]=__builtin_amdgcn_mfma_f32_32x32x16_bf16(pa0,PK(0),o[d0],0,0,0);
    o[d0]=__builtin_amdgcn_mfma_f32_32x32x16_bf16(pa1,PK(1),o[d0],0,0,0);
    o[d0]=__builtin_amdgcn_mfma_f32_32x32x16_bf16(pa2,PK(2),o[d0],0,0,0);
    o[d0]=__builtin_amdgcn_mfma_f32_32x32x16_bf16(pa3,PK(3),o[d0],0,0,0);
    #undef PK
  }
}

#ifndef ATTN_STORE16
#define ATTN_STORE16(p,v) (*(u32x4*)(p)=(v))
#endif
template<int THRL,int MODE> __device__ __forceinline__ void attn_unit(int b,int h,int qb,const bf16*Q,const bf16*__restrict__ K,const bf16*__restrict__ V,bf16*O,const bf16*__restrict__ G,char*shm,
    const float*kbl,float slope2,const unsigned long long*__restrict__ Mb,int t0){
  const int tid=threadIdx.x,lane=tid&63,r32=lane&31,hi=lane>>5; const int wid=__builtin_amdgcn_readfirstlane(tid>>6);
  const long rowbase=(long)b*SEQ; const int q0=qb*QB;
  const bf16*Qw=Q+(rowbase+q0+wid*QBLK)*DM+h*D;
  const bf16*Kh=K+rowbase*DM+h*D,*Vh=V+rowbase*DM+h*D;
  const unsigned lds0=(unsigned)(uintptr_t)shm;
  float*wsf=(float*)(shm+LDS_WS)+wid*64;
  const bf16*ksrc=Kh+(long)lane*DM+wid*8;
  const bf16*vsrc=Vh+(long)(16*(wid&3)+(lane>>2))*DM+(wid>>2)*32+(lane&3)*8;
  const unsigned kdst=lds0+LDS_K+wid*1024, vdst=lds0+LDS_V+wid*1024;
  #define DMA_K(t,slot) glds16(ksrc+(long)(t)*KVBLK*DM,(unsigned)__builtin_amdgcn_readfirstlane(kdst+(slot)))
  #define DMA_V(t,slot) glds16(vsrc+(long)(t)*KVBLK*DM,(unsigned)__builtin_amdgcn_readfirstlane(vdst+(slot)))
  const int vb0=(int)(lds0+LDS_V)+((lane>>4)&1)*32+(lane&3)*8+(4*hi+((lane&15)>>2))*64;
  const char*Kbase=shm+LDS_K; bf16x8 kf[8];
  const lds_cptr shm3=(lds_cptr)shm; const lds_cptr kp0=shm3+LDS_K+hi*1024+r32*16; const lds_cptr vp0=shm3+LDS_V+((lane>>4)&1)*32+(lane&3)*8+(4*hi+((lane&15)>>2))*64;
  const int NT=(q0+QB)/KVBLK;
  DMA_K(t0,0);DMA_V(t0,0);DMA_K(t0+1,SLOTB);
  bf16x8 qr[4];
  #pragma unroll
  for(int d0=0;d0<4;++d0)qr[d0]=*reinterpret_cast<const bf16x8*>(&Qw[(long)r32*DM+d0*16+hi*8]);
  float mhat=0.f,l_reg=0.f;f32x16 o[2];o[0]=f32x16{};o[1]=f32x16{};float nm=0.f;
  typedef __attribute__((address_space(3))) const f32x4_t* lds_f4p; typedef __attribute__((address_space(3))) const unsigned long long* lds_u64p;
  const lds_f4p kb4=(lds_f4p)kbl;
  const lds_cptr mrow3=(lds_cptr)shm+LDS_MASK+wid*MASK_WAVE+r32*MASK_ROW;
  if(MODE==1){ const unsigned long long*msrc=Mb+((size_t)(q0+wid*QBLK+r32)*32+16*hi); u32x4 tm[8];
    _Pragma("unroll") for(int i=0;i<8;++i)tm[i]=*reinterpret_cast<const u32x4*>(msrc+2*i);
    __attribute__((address_space(3))) unsigned long long*md=(__attribute__((address_space(3))) unsigned long long*)((__attribute__((address_space(3))) char*)shm+LDS_MASK+wid*MASK_WAVE+r32*MASK_ROW+hi*128);
    _Pragma("unroll") for(int i=0;i<8;++i){ md[2*i]=((unsigned long long)tm[i][1]<<32)|tm[i][0]; md[2*i+1]=((unsigned long long)tm[i][3]<<32)|tm[i][2]; } }
  #define CINIT(C0,C1,t) do{ if(MODE==0){ const int i4_=16*(t)+hi; \
      _Pragma("unroll") for(int g_=0;g_<4;++g_){ const f32x4_t a_=kb4[i4_+2*g_], b_=kb4[i4_+8+2*g_]; \
        _Pragma("unroll") for(int j_=0;j_<4;++j_){ C0[4*g_+j_]=nm+a_[j_]; C1[4*g_+j_]=nm+b_[j_]; } } } \
    else { const unsigned long long w_=*(lds_u64p)(mrow3+8*(t)); const unsigned wl_=((unsigned)w_)>>(4*hi), wh_=((unsigned)(w_>>32))>>(4*hi); \
      float sl_=slope2; asm volatile("":"+v"(sl_)); const float base_=nm+sl_*(float)(64*(t)+4*hi);     \
      _Pragma("unroll") for(int r_=0;r_<16;++r_){ const int b_=(r_&3)+8*(r_>>2); \
        C0[r_]=((wl_>>b_)&1u)?__builtin_fmaf(sl_,(float)b_,base_):-INFINITY; C1[r_]=((wh_>>b_)&1u)?__builtin_fmaf(sl_,(float)(b_+32),base_):-INFINITY; } } }while(0)
  const int qrel=wid*QBLK+r32;
  #define CMASK(P0,P1,t) do{ if(MODE==0){int jb_=(t)-(NT-4); if(jb_>=0)cmask(P0,P1,jb_,qrel,hi);} }while(0)
  bool resc=false;
  #define START(P0,P1) do{ const float rm=rowmax(P0,P1); resc=false; \
    { const float dl=(MODE==1)?__builtin_fmaxf(rm,-1.0e4f):rm; mhat=fadd_s(mhat,dl); \
      _Pragma("unroll") for(int r=0;r<16;++r){P0[r]=fsub_s(P0[r],dl);P1[r]=fsub_s(P1[r],dl);} \
      nm=-mhat; } \
    _Pragma("unroll") for(int r=0;r<16;++r)P0[r]=__builtin_amdgcn_exp2f(P0[r]); }while(0)
  #define RESC() do{ if(resc){ asm volatile("s_waitcnt lgkmcnt(0)":::"memory"); \
      _Pragma("unroll") for(int d_=0;d_<2;++d_) _Pragma("unroll") for(int r=0;r<16;++r)o[d_][r]*=wsf[crow(r,hi)]; } }while(0)
  f32x16 pA0,pA1,pB0,pB1;
  int sl_prev=0,sl_cur=0,sl_next=SLOTB;
  #define ROT() do{sl_prev=sl_cur;sl_cur=sl_next;sl_next=(sl_next==(NSLOT-1)*SLOTB)?0:sl_next+SLOTB;}while(0)
  DMA_K(t0+2,2*SLOTB);
  WAIT_BAR(3);
  CINIT(pA0,pA1,t0); qkt(pA0,pA1,Kbase,qr,r32,hi);asm volatile("s_nop 15\n\ts_nop 7":"+v"(pA0),"+v"(pA1));CMASK(pA0,pA1,t0);
  START(pA0,pA1);
  _Pragma("unroll") for(int r=0;r<16;++r)pA1[r]=__builtin_amdgcn_exp2f(pA1[r]);
  WAIT_BAR(0);
  DMA_K(t0+3,0);DMA_V(t0+1,SLOTB);
  ROT();
  kload8(kf,kp0+sl_cur);
  WAIT_BAR(2);
  s16x4 vlo[8],vhi[8]; u32x4 pw0,pw1,pw2,pw3;
  #define PKW(P,B) cvtpk_s(P[B],P[B+1])
  #define PAF(k) __builtin_bit_cast(bf16x8,pw##k)
  #define VFR(i) (bf16x8){vlo[i][0],vlo[i][1],vlo[i][2],vlo[i][3],vhi[i][0],vhi[i][1],vhi[i][2],vhi[i][3]}
  #define PIN(x) asm volatile("":"+v"(x))
  #define MX3(a,b,c) __builtin_fmaxf(__builtin_fmaxf((a),(b)),(c))
  #define GAPA(MF,A0,A1,A2,A3,W0,W1,PW) do{ MF; sacc+=A0; sacc+=A1; sacc+=A2; sacc+=A3; PIN(sacc); W0; W1; PIN(PW); SBAR(); }while(0)
  #define EX(v) __builtin_amdgcn_exp2f(v)
  #define GAPB(MF,X,B) do{ MF; X[B]=EX(X[B]); X[B+1]=EX(X[B+1]); X[B+2]=EX(X[B+2]); X[B+3]=EX(X[B+3]); PIN(X); SBAR(); }while(0)
  #define VRD(i) do{ vlo[i]=vtr(vp_+(((i)>>2)*4096+((i)&3)*1024)); vhi[i]=vtr(vp_+(((i)>>2)*4096+((i)&3)*1024+512)); }while(0)
  #define KRD(G,j) do{ if(G){ kload2(kf,kp0+sl_next,j); SBAR(); } }while(0)
  #define STEP(C0,C1,P0,P1,t,GK,GV,GL) do{ SBAR(); \
    const lds_cptr vp_=vp0+sl_prev; \
    CINIT(C0,C1,t); SBAR(); \
    VRD(0); SBAR(); float sacc=(P0[0]+P0[1]); \
    GAPA(C0=__builtin_amdgcn_mfma_f32_32x32x16_bf16(kf[0],qr[0],C0,0,0,0), P0[2],P0[3],P0[4],P0[5],     pw0[0]=PKW(P0,0), pw0[1]=PKW(P0,2), pw0); \
    VRD(4); SBAR(); GAPA(C1=__builtin_amdgcn_mfma_f32_32x32x16_bf16(kf[1],qr[0],C1,0,0,0), P0[6],P0[7],P0[8],P0[9],     pw0[2]=PKW(P0,4), pw0[3]=PKW(P0,6), pw0); \
    VRD(1); SBAR(); GAPA(C0=__builtin_amdgcn_mfma_f32_32x32x16_bf16(kf[2],qr[1],C0,0,0,0),   P0[10],P0[11],P0[12],P0[13], pw1[0]=PKW(P0,8), pw1[1]=PKW(P0,10), pw1); \
    VRD(5); SBAR(); GAPA(C1=__builtin_amdgcn_mfma_f32_32x32x16_bf16(kf[3],qr[1],C1,0,0,0),   P0[14],P0[15],P1[0],P1[1],   pw1[2]=PKW(P0,12),pw1[3]=PKW(P0,14), pw1); \
    VRD(2); SBAR(); GAPA(C0=__builtin_amdgcn_mfma_f32_32x32x16_bf16(kf[4],qr[2],C0,0,0,0),   P1[2],P1[3],P1[4],P1[5],     pw2[0]=PKW(P1,0), pw2[1]=PKW(P1,2), pw2); \
    VRD(6); SBAR(); GAPA(C1=__builtin_amdgcn_mfma_f32_32x32x16_bf16(kf[5],qr[2],C1,0,0,0),   P1[6],P1[7],P1[8],P1[9],     pw2[2]=PKW(P1,4), pw2[3]=PKW(P1,6), pw2); \
    VRD(3); SBAR(); GAPA(C0=__builtin_amdgcn_mfma_f32_32x32x16_bf16(kf[6],qr[3],C0,0,0,0),   P1[10],P1[11],P1[12],P1[13], pw3[0]=PKW(P1,8), pw3[1]=PKW(P1,10), pw3); \
    VRD(7); SBAR(); GAPA(C1=__builtin_amdgcn_mfma_f32_32x32x16_bf16(kf[7],qr[3],C1,0,0,0),   P1[14],P1[15],0.f,0.f,       pw3[2]=PKW(P1,12),pw3[3]=PKW(P1,14), pw3); \
    l_reg+=sacc; \
    if(GK){DMA_K((t)+3,sl_cur);} if(GV){DMA_V((t)+1,sl_next);} \
    CMASK(C0,C1,t); \
    { float a=MX3(C0[0],C0[1],C1[0]),b=MX3(C0[2],C0[3],C1[1]); a=MX3(a,C1[2],C1[3]); \
      _Pragma("unroll") for(int r=4;r<16;r+=4){a=MX3(a,C0[r],C0[r+1]);b=MX3(b,C0[r+2],C0[r+3]);a=MX3(a,C1[r],C1[r+1]);b=MX3(b,C1[r+2],C1[r+3]);} \
      float rm=__builtin_fmaxf(a,b); { auto rr=__builtin_amdgcn_permlane32_swap(__float_as_uint(rm),__float_as_uint(rm),false,false); rm=__builtin_fmaxf(__uint_as_float(rr[0]),__uint_as_float(rr[1])); } \
      resc=false; \
      if(__builtin_expect(__any(rm>(float)THRL),0)){ const float dl=__builtin_fmaxf(rm,0.f); mhat+=dl; \
        _Pragma("unroll") for(int r=0;r<16;++r){C0[r]-=dl;C1[r]-=dl;} \
        nm=-mhat; \
        const float f=__builtin_amdgcn_exp2f(-dl); l_reg*=f; if(hi==0)wsf[r32]=f; resc=true; } } \
    SBAR(); \
    GAPB(o[0]=__builtin_amdgcn_mfma_f32_32x32x16_bf16(PAF(0),VFR(0),o[0],0,0,0), C0,0); \
    GAPB(o[1]=__builtin_amdgcn_mfma_f32_32x32x16_bf16(PAF(0),VFR(4),o[1],0,0,0), C0,4); \
    KRD(GL,0); GAPB(o[0]=__builtin_amdgcn_mfma_f32_32x32x16_bf16(PAF(1),VFR(1),o[0],0,0,0), C0,8); \
    KRD(GL,1); GAPB(o[1]=__builtin_amdgcn_mfma_f32_32x32x16_bf16(PAF(1),VFR(5),o[1],0,0,0), C0,12); \
    KRD(GL,2); GAPB(o[0]=__builtin_amdgcn_mfma_f32_32x32x16_bf16(PAF(2),VFR(2),o[0],0,0,0), C1,0); \
    KRD(GL,3); GAPB(o[1]=__builtin_amdgcn_mfma_f32_32x32x16_bf16(PAF(2),VFR(6),o[1],0,0,0), C1,4); \
    GAPB(o[0]=__builtin_amdgcn_mfma_f32_32x32x16_bf16(PAF(3),VFR(3),o[0],0,0,0), C1,8); \
    GAPB(o[1]=__builtin_amdgcn_mfma_f32_32x32x16_bf16(PAF(3),VFR(7),o[1],0,0,0), C1,12); \
    }while(0)
  int t=t0+1;
  #undef CMASK
  #define CMASK(P0,P1,t) do{}while(0)
  for(;t+5<NT;t+=2){
    STEP(pB0,pB1,pA0,pA1,t,true,true,true);     WAIT_BAR(2); RESC(); ROT();
    STEP(pA0,pA1,pB0,pB1,t+1,true,true,true);   WAIT_BAR(2); RESC(); ROT();
  }
  #undef CMASK
  #define CMASK(P0,P1,t) do{ if(MODE==0){int jb_=(t)-(NT-4); if(jb_>=0)cmask(P0,P1,jb_,qrel,hi);} }while(0)
  #define ENDW(tt) do{ if((tt)+3<NT){WAIT_BAR(2);} else if((tt)+2<NT){WAIT_BAR(1);} else {WAIT_BAR(0);} }while(0)
  for(;t+1<NT;t+=2){
    STEP(pB0,pB1,pA0,pA1,t,(t+3<NT),(t+1<NT),(t+1<NT));       ENDW(t);   RESC(); ROT();
    STEP(pA0,pA1,pB0,pB1,t+1,(t+4<NT),(t+2<NT),(t+2<NT));     ENDW(t+1); RESC(); ROT();
  }
  STEP(pB0,pB1,pA0,pA1,NT-1,false,false,false); RESC();
  { float sacc=pB0[0]+pB0[1]; _Pragma("unroll") for(int r=2;r<16;++r)sacc+=pB0[r]; _Pragma("unroll") for(int r=0;r<16;++r)sacc+=pB1[r]; l_reg+=sacc;
    pw0=(u32x4){PKW(pB0,0),PKW(pB0,2),PKW(pB0,4),PKW(pB0,6)};pw1=(u32x4){PKW(pB0,8),PKW(pB0,10),PKW(pB0,12),PKW(pB0,14)};pw2=(u32x4){PKW(pB1,0),PKW(pB1,2),PKW(pB1,4),PKW(pB1,6)};pw3=(u32x4){PKW(pB1,8),PKW(pB1,10),PKW(pB1,12),PKW(pB1,14)};
    SBAR(); pv(o,vb0+sl_cur,PAF(0),PAF(1),PAF(2),PAF(3)); }
  #undef PKW
  #undef PAF
  #undef VFR
  #undef PIN
  #undef MX3
  #undef GAPA
  #undef GAPB
  #undef EX
  #undef VRD
  #undef KRD
  #undef STEP
  #undef ENDW
  {auto rr=__builtin_amdgcn_permlane32_swap(__float_as_uint(l_reg),__float_as_uint(l_reg),false,false);l_reg=__uint_as_float(rr[0])+__uint_as_float(rr[1]);}
  if(hi==0)wsf[32+r32]=l_reg;asm volatile("s_waitcnt lgkmcnt(0)":::"memory");
  float rli[16];
  #pragma unroll
  for(int r=0;r<16;++r)rli[r]=__builtin_amdgcn_rcpf(wsf[32+crow(r,hi)]);
  bf16*Ow=O+(rowbase+q0+wid*QBLK)*DM+h*D; const bf16*Gw=G+(rowbase+q0+wid*QBLK)*DM+h*D;
  { bf16*stg=(bf16*)(shm+LDS_OST)+wid*2048;
    #pragma unroll
    for(int r=0;r<16;++r){const int orow=crow(r,hi);
      #pragma unroll
      for(int d0=0;d0<2;++d0)stg[orow*64+d0*32+r32]=__float2bfloat16(o[d0][r]*rli[r]);}
    asm volatile("s_waitcnt lgkmcnt(0)":::"memory");
    #pragma unroll
    for(int i=0;i<4;++i){const int row=i*8+(lane>>3),ch=lane&7; u32x4 v=*(const u32x4*)(stg+row*64+ch*8); const u32x4 g=*reinterpret_cast<const u32x4*>(Gw+(long)row*DM+ch*8);
      _Pragma("unroll") for(int k=0;k<4;++k){ const float vl=__uint_as_float(v[k]<<16),vh=__uint_as_float(v[k]&0xffff0000u),gl=__uint_as_float(g[k]<<16),gh=__uint_as_float(g[k]&0xffff0000u); v[k]=cvtpk_s(vl*gl,vh*gh); }
      ATTN_STORE16(Ow+(long)row*DM+ch*8,v);} }
  asm volatile("s_waitcnt lgkmcnt(0)\n\ts_barrier":::"memory");
  #undef DMA_K
  #undef DMA_V
  #undef CMASK
  #undef CINIT
  #undef START
  #undef RESC
  #undef ROT
}
#undef SBAR
#undef WAIT_BAR
}

constexpr int NWAVES = 8;
#ifndef MK_N_LAUNCHES
#define MK_N_LAUNCHES 1
#endif
constexpr int N_PHASES = 7;
constexpr int N_LAUNCHES = MK_N_LAUNCHES;
constexpr size_t MiB = 1u << 20;
constexpr size_t WS_CTL = 0, CTL_ZERO_BYTES = 64 * 1024;
constexpr size_t WS_MODP = 1 * MiB;
constexpr size_t WS_GATE = 2 * MiB;
constexpr size_t WS_WIN = 4 * MiB;
constexpr size_t WS_WOUT = 14 * MiB;
constexpr size_t WS_FL = 16 * MiB;
constexpr size_t WS_WI = 17 * MiB;
constexpr size_t WS_KI = 18 * MiB;
constexpr size_t WS_RSQ = 22 * MiB;
constexpr size_t WS_MASK = 24 * MiB;
constexpr size_t WS_XN = 32 * MiB;
constexpr size_t WS_Q = 96 * MiB, WS_K = 160 * MiB, WS_V = 224 * MiB, WS_G = 288 * MiB;
constexpr size_t WS_QI = 352 * MiB;
constexpr size_t WS_END = 384 * MiB;
constexpr int CW_BAR = 1024;

constexpr int RING_OFF = 0, RING_BYTES = 131072;
constexpr int UP_OFF = 131072;
constexpr int LDS_BYTES = 163840, LDSCTL_OFF = LDS_BYTES - 512, MISC_OFF = LDSCTL_OFF;
static_assert(attn_body::LDS_BYTES_DSA <= LDSCTL_OFF, "DSA attention scratch fits");

#define GAS __attribute__((address_space(1)))
#define LAS __attribute__((address_space(3)))
typedef unsigned short bf16;
typedef unsigned v4u __attribute__((ext_vector_type(4)));
typedef float f32x4 __attribute__((ext_vector_type(4)));
typedef float f32x16 __attribute__((ext_vector_type(16)));
typedef short bf16x8 __attribute__((ext_vector_type(8)));
typedef GAS unsigned gu32;
typedef GAS unsigned long long gu64;
#define RLX_AGENT __ATOMIC_RELAXED, __HIP_MEMORY_SCOPE_AGENT
#define LDS_WAIT() asm volatile("s_waitcnt lgkmcnt(0)" ::: "memory")
#define VM_WAIT() asm volatile("s_waitcnt vmcnt(0)" ::: "memory")
__device__ __forceinline__ unsigned f2bf(float f) { unsigned u = __builtin_bit_cast(unsigned, f); return (u + 0x7fffu + ((u >> 16) & 1u)) >> 16; }
__device__ __forceinline__ unsigned pk2(float lo, float hi) { return f2bf(lo) | (f2bf(hi) << 16); }
#define XB_TMO      128
#define XB_XCNT(j)  (256  + 64 * (j))
#define XB_XSUB(j)  (1280 + 64 * (j))
#define XB_XGEN(j)  (2304 + 64 * (j))
#define XB_TOP      3328
#define XB_TOPGEN   3392
#define XCD_BAR_WORDS 3456
#define XB_SPIN_CAP (1u << 18)

__device__ __forceinline__ unsigned xb_ld(unsigned* p)              { return __hip_atomic_load(p, __ATOMIC_RELAXED, __HIP_MEMORY_SCOPE_AGENT); }
__device__ __forceinline__ unsigned xb_add(unsigned* p, unsigned v) { return __hip_atomic_fetch_add(p, v, __ATOMIC_RELAXED, __HIP_MEMORY_SCOPE_AGENT); }
__device__ __forceinline__ unsigned xb_xcc_id() { return (unsigned)__builtin_amdgcn_s_getreg((3 << 11) | 20) & 0xFu; }
#define XB_SPIN(cond, bar) do { unsigned _sp = 0; while (cond) { __builtin_amdgcn_s_sleep(1); \
    if ((++_sp & 255u) == 0u) { if (xb_ld(&(bar)[XB_TMO])) break; if (_sp > XB_SPIN_CAP) { atomicAdd(&(bar)[XB_TMO], 1u); break; } } } } while (0)

struct XcdBarrier {
    unsigned* bar; unsigned x;
    volatile LAS unsigned* st;
};

__device__ __forceinline__ XcdBarrier xcd_barrier_post(unsigned* bar, volatile LAS unsigned* st) {
    XcdBarrier b; b.bar = bar; b.x = xb_xcc_id(); b.st = st;
    if (threadIdx.x == 0) (void)xb_add(&bar[XB_XCNT(b.x)], 1u);
    return b;
}
__device__ __forceinline__ void xcd_barrier_complete(unsigned* bar, unsigned x, unsigned& nloc, unsigned& nx) {
    const unsigned G = gridDim.x * gridDim.y * gridDim.z;
    unsigned sum, cnt, mine, sp = 0u;
    for (;;) {
        sum = 0u; cnt = 0u; mine = 0u;
#pragma unroll
        for (unsigned j = 0; j < 16; ++j) { const unsigned c = xb_ld(&bar[XB_XCNT(j)]); sum += c; cnt += (c > 0u) ? 1u : 0u; mine = (j == x) ? c : mine; }
        if (sum == G) break;
        __builtin_amdgcn_s_sleep(1);
        if ((++sp & 255u) == 0u) { if (xb_ld(&bar[XB_TMO])) break; if (sp > XB_SPIN_CAP) { atomicAdd(&bar[XB_TMO], 1u); break; } }
    }
    nloc = mine > 0u ? mine : 1u; nx = cnt > 0u ? cnt : 1u;
}

__device__ __forceinline__ void xcd_barrier(const XcdBarrier& b) {
    asm volatile("s_waitcnt vmcnt(0)" ::: "memory");
    __syncthreads();
    if (threadIdx.x == 0) {
        unsigned* bar = b.bar;
        __builtin_amdgcn_s_waitcnt(0);
        unsigned nloc = b.st[0], nx = b.st[1];
        if (nloc == 0u) { xcd_barrier_complete(bar, b.x, nloc, nx); b.st[0] = nloc; b.st[1] = nx; }
        const unsigned old = xb_add(&bar[XB_XSUB(b.x)], 1u);
        const unsigned gen = old / nloc;
        if (old + 1u == (gen + 1u) * nloc) {
            __builtin_amdgcn_fence(__ATOMIC_RELEASE, "agent");
            asm volatile("s_waitcnt vmcnt(0)" ::: "memory");
            const unsigned og = xb_add(&bar[XB_TOP], 1u);
            const unsigned tg = og / nx;
            if (og + 1u == (tg + 1u) * nx) xb_add(&bar[XB_TOPGEN], 1u);
            else XB_SPIN(xb_ld(&bar[XB_TOPGEN]) == tg, bar);
            __builtin_amdgcn_fence(__ATOMIC_ACQUIRE, "agent");
            xb_add(&bar[XB_XGEN(b.x)], 1u);
            asm volatile("s_waitcnt vmcnt(0)" ::: "memory");
        } else {
            XB_SPIN(xb_ld(&bar[XB_XGEN(b.x)]) == gen, bar);
            __builtin_amdgcn_fence(__ATOMIC_ACQUIRE, "agent");
            asm volatile("s_waitcnt vmcnt(0)" ::: "memory");
        }
    }
    __syncthreads();
}

struct Frame {
    LAS unsigned char* lds;
    volatile LAS unsigned* MISC;
    int tid, lane, wave;
    int vcu, G;
};
__device__ __forceinline__ float wave_sum(float v) {
#pragma unroll
    for (int o = 1; o < 64; o <<= 1) v += __shfl_xor(v, o);
    return v;
}

__device__ __forceinline__ int win_src_col(int n) {
    if (n < 4096) { const int seg = n >> 9, o = n & 511;
        const int base = (seg == 0) ? 0 : (seg == 1) ? 2056 : (seg == 2) ? 512 : (seg == 3) ? 2568 : (seg == 4) ? 1024 : (seg == 5) ? 3080 : (seg == 6) ? 1544 : 4176;
        return base + o; }
    if (n < 4608) return 3592 + (n - 4096);
    if (n < 4616) return 1536 + (n - 4608);
    if (n < 4680) return 4104 + (n - 4616);
    if (n < 4688) return 4168 + (n - 4680);
    return -1;
}
__device__ __forceinline__ void transpose_item(const float* W, int Nsrc, int K, bf16* WT, int n0, int k0, bool permuted, LAS float* scr, int lane) {
    const int n = n0 + (lane & 31); const int sc = permuted ? win_src_col(n) : n;
#pragma unroll 8
    for (int i = 0; i < 32; ++i) { const int kk = 2 * i + (lane >> 5); scr[kk * 33 + (lane & 31)] = (sc >= 0) ? W[(size_t)(k0 + kk) * Nsrc + sc] : 0.f; }
    LDS_WAIT(); asm volatile("" ::: "memory");
    const int c = lane & 7;
#pragma unroll
    for (int j = 0; j < 4; ++j) { const int nn = (lane >> 3) + 8 * j; const LAS float* s = scr + (8 * c) * 33 + nn;
        v4u o; o.x = pk2(s[0 * 33], s[1 * 33]); o.y = pk2(s[2 * 33], s[3 * 33]); o.z = pk2(s[4 * 33], s[5 * 33]); o.w = pk2(s[6 * 33], s[7 * 33]);
        *(GAS v4u*)(WT + (size_t)(n0 + nn) * K + k0 + 8 * c) = o; }
    LDS_WAIT(); asm volatile("" ::: "memory");
}
__device__ __forceinline__ void p0_prologue(Frame& F, const float* c, const float* w_mod, const float* w_in, const float* w_out, float* MODP, bf16* WIN, bf16* WOUT) {
    if (F.vcu < 192) {
        const int j0 = (F.vcu % 48) * 64, sl = F.vcu / 48, k0 = sl * 256;
        LAS float* cact = (LAS float*)(F.lds + RING_OFF);
        LAS float* red = (LAS float*)(F.lds + RING_OFF + 16384);
        for (int idx = F.tid; idx < 4096; idx += 512) { const int kk = idx >> 4, b = idx & 15; const float cv = c[(size_t)b * 1024 + k0 + kk]; cact[kk * 16 + b] = cv / (1.0f + expf(-cv)); }
        __syncthreads();
        float acc[16];
#pragma unroll
        for (int b = 0; b < 16; ++b) acc[b] = 0.f;
#pragma unroll 4
        for (int kk = 0; kk < 32; ++kk) { const int k = 32 * F.wave + kk; const float wv = w_mod[(size_t)(k0 + k) * 3072 + j0 + F.lane];
            const LAS f32x4* cp = (const LAS f32x4*)(cact + k * 16);
#pragma unroll
            for (int q = 0; q < 4; ++q) { const f32x4 cv = cp[q];
#pragma unroll
                for (int e = 0; e < 4; ++e) acc[4 * q + e] += wv * cv[e]; } }
#pragma unroll
        for (int b = 0; b < 16; ++b) red[(F.wave * 16 + b) * 64 + F.lane] = acc[b];
        __syncthreads();
        for (int o = F.tid; o < 1024; o += 512) { const int b = o >> 6, jj = o & 63; float s = 0.f;
#pragma unroll
            for (int w = 0; w < 8; ++w) s += red[(w * 16 + b) * 64 + jj];
            MODP[(size_t)(sl * 16 + b) * 3072 + j0 + jj] = s; }
        __syncthreads();
    }
    LAS float* scr = (LAS float*)(F.lds + RING_OFF + F.wave * 16384);
    const int gw = F.vcu * NWAVES + F.wave, NGW = F.G * NWAVES;
    constexpr int NB_IN = N_INP / 32, I_IN = 16 * NB_IN, I_OUT = 16 * 32;
    for (int it = gw; it < I_IN + I_OUT; it += NGW) {
        if (it < I_IN) { const int kb = it / NB_IN, nb = it % NB_IN; transpose_item(w_in, N_IN, 1024, WIN, 32 * nb, 64 * kb, true, scr, F.lane); }
        else { const int r = it - I_IN, kb = r / 32, nb = r % 32; transpose_item(w_out, 1024, 1024, WOUT, 32 * nb, 64 * kb, false, scr, F.lane); }
    }
}

__device__ __forceinline__ void p1_norm(Frame& F, const float* x, const float* b_mod, const float* gain, const float* MODP, float* GATE, bf16* XN) {
    const int g = blockIdx.x, b = g >> 4;
    LAS float* A_l = (LAS float*)(F.lds + UP_OFF); LAS float* S_l = A_l + 1024;
    for (int k = F.tid; k < 1024; k += 512) {
        float sh = b_mod[k], sc = b_mod[1024 + k], gt = b_mod[2048 + k];
#pragma unroll
        for (int s = 0; s < 4; ++s) { const float* mp = MODP + (size_t)(s * 16 + b) * 3072; sh += mp[k]; sc += mp[1024 + k]; gt += mp[2048 + k]; }
        A_l[k] = gain[k] * (1.0f + sc); S_l[k] = sh;
        if ((g & 15) == 0) GATE[(size_t)b * 1024 + k] = gt;
    }
    __syncthreads();
    for (int r = F.wave; r < 128; r += NWAVES) { const size_t row = (size_t)g * 128 + r;
        const GAS f32x4* xr = (const GAS f32x4*)(x + row * 1024) + F.lane;
        f32x4 v[4]; float ss = 0.f;
#pragma unroll
        for (int j = 0; j < 4; ++j) { v[j] = xr[64 * j]; ss += (v[j].x * v[j].x + v[j].y * v[j].y) + (v[j].z * v[j].z + v[j].w * v[j].w); }
        const float rinv = 1.0f / sqrtf(wave_sum(ss) * (1.0f / 1024.0f) + RMS_EPS);
        GAS unsigned long long* o8 = (GAS unsigned long long*)(XN + row * 1024) + F.lane;
#pragma unroll
        for (int j = 0; j < 4; ++j) { const f32x4 a = *(const LAS f32x4*)(A_l + 4 * F.lane + 256 * j), s = *(const LAS f32x4*)(S_l + 4 * F.lane + 256 * j);
            const f32x4 o = v[j] * rinv * a + s;
            o8[64 * j] = (unsigned long long)pk2(o.x, o.y) | ((unsigned long long)pk2(o.z, o.w) << 32); }
    }
}

__device__ __forceinline__ void fox_prologue(Frame& F, const float* FL, const bf16* Q, const bf16* K, int b, int h) {
    LAS float* kbl = (LAS float*)(F.lds + UP_OFF); LAS float* wtot = kbl + SEQ; LAS unsigned* fx = (LAS unsigned*)(kbl + SEQ + 8);
    if (F.tid < 16) fx[F.tid] = 0u;
    const int s0 = 4 * F.tid; float p[4];
#pragma unroll
    for (int j = 0; j < 4; ++j) p[j] = FL[((size_t)b * SEQ + s0 + j) * 8 + h];
    p[1] += p[0]; p[2] += p[1]; p[3] += p[2];
    float sc = p[3];
#pragma unroll
    for (int o = 1; o < 64; o <<= 1) { const float t = __shfl_up(sc, o); if (F.lane >= o) sc += t; }
    if (F.lane == 63) wtot[F.wave] = sc;
    __syncthreads();
    float off = sc - p[3];
    for (int w = 0; w < F.wave; ++w) off += wtot[w];
#pragma unroll
    for (int j = 0; j < 4; ++j) kbl[s0 + j] = -(off + p[j]);
    float kmx = 0.f;
#pragma unroll 1
    for (int j = 0; j < 4; ++j) { const size_t row = (size_t)b * SEQ + F.tid + 512 * j; float kq = 0.f, qq = 0.f;
#pragma unroll
        for (int c = 0; c < 8; ++c) { const v4u kv = *(const v4u*)(K + row * 1024 + h * 64 + 8 * c), qv = *(const v4u*)(Q + row * 1024 + h * 64 + 8 * c);
#pragma unroll
            for (int e = 0; e < 4; ++e) { const float k0 = __uint_as_float(kv[e] << 16), k1 = __uint_as_float(kv[e] & 0xffff0000u), q0 = __uint_as_float(qv[e] << 16), q1 = __uint_as_float(qv[e] & 0xffff0000u);
                kq += k0 * k0 + k1 * k1; qq += q0 * q0 + q1 * q1; } }
        kmx = fmaxf(kmx, kq);
        (void)__hip_atomic_fetch_max(&fx[8 + ((F.tid + 512 * j) >> 8)], __float_as_uint(qq), __ATOMIC_RELAXED, __HIP_MEMORY_SCOPE_WORKGROUP); }
    (void)__hip_atomic_fetch_max(&fx[0], __float_as_uint(kmx), __ATOMIC_RELAXED, __HIP_MEMORY_SCOPE_WORKGROUP);
    __syncthreads();
}
constexpr float FOX_SKIP_THR = 48.0f;
__device__ __forceinline__ int fox_first_tile(Frame& F, int qb) {
    const LAS float* kbl = (const LAS float*)(F.lds + UP_OFF); const LAS unsigned* fx = (const LAS unsigned*)(kbl + SEQ + 8);
    const float kmax = sqrtf(__uint_as_float(fx[0])) * 1.01f, qmax = sqrtf(__uint_as_float(fx[8 + qb])) * 1.01f;
    const float need = FOX_SKIP_THR + 2.0f * qmax * kmax; const float kq0 = kbl[256 * qb];
    const int NT = 4 * qb + 4; int t0 = 0;
    for (int j = 0; j + 4 < NT; ++j) { if (kq0 - kbl[64 * j + 63] > need) t0 = j + 1; else break; }
    t0 &= ~1; return t0 < NT - 4 ? t0 : NT - 4;
}

__device__ __forceinline__ int wave_total_i32(int x) {
    x += __builtin_amdgcn_update_dpp(0, x, 0x111, 0xf, 0xf, true); x += __builtin_amdgcn_update_dpp(0, x, 0x112, 0xf, 0xf, true);
    x += __builtin_amdgcn_update_dpp(0, x, 0x114, 0xf, 0xf, true); x += __builtin_amdgcn_update_dpp(0, x, 0x118, 0xf, 0xf, true);
    x += __builtin_amdgcn_update_dpp(0, x, 0x142, 0xa, 0xf, false); x += __builtin_amdgcn_update_dpp(0, x, 0x143, 0xc, 0xf, false);
    return __builtin_amdgcn_readlane(x, 63);
}
typedef short s16x2 __attribute__((ext_vector_type(2)));
template <int ND> __device__ __forceinline__ void select_rows2(const LAS unsigned char* krowA, const LAS unsigned char* krowB, int qswA, int qswB, int NT, int lane,
                                                                unsigned long long& wordA, unsigned long long& wordB) {
    s16x2 kA[ND], kB[ND];
#pragma unroll
    for (int i = 0; i < ND; ++i) { const int d = lane + 64 * i; const bool ok = (2 * d < 64 * NT);
        unsigned va = 0x80008000u, vb = 0x80008000u;
        if (ok) { va = *(const LAS unsigned*)(krowA + (((d >> 1) ^ qswA) * 8) + (d & 1) * 4); vb = *(const LAS unsigned*)(krowB + (((d >> 1) ^ qswB) * 8) + (d & 1) * 4); }
        kA[i] = __builtin_bit_cast(s16x2, va); kB[i] = __builtin_bit_cast(s16x2, vb); }
    constexpr int TOTAL = 128 * ND;
    int loA = -32767, hiA = 32768, chiA = 0, loB = -32767, hiB = 32768, chiB = 0;
#pragma unroll 1
    for (int it = 0; it < 16; ++it) { const int midA = (loA + hiA) >> 1, midB = (loB + hiB) >> 1;
        const s16x2 tA = {(short)midA, (short)midA}, tB = {(short)midB, (short)midB};
        s16x2 a0 = {0, 0}, a1 = {0, 0}, b0 = {0, 0}, b1 = {0, 0};
#pragma unroll
        for (int i = 0; i < ND; i += 2) {
            a0 -= (__builtin_elementwise_sub_sat(kA[i], tA) >> 15); b0 -= (__builtin_elementwise_sub_sat(kB[i], tB) >> 15);
            a1 -= (__builtin_elementwise_sub_sat(kA[i + 1], tA) >> 15); b1 -= (__builtin_elementwise_sub_sat(kB[i + 1], tB) >> 15); }
        const s16x2 sa = a0 + a1, sb = b0 + b1;
        const int ltA = wave_total_i32((int)sa[0] + (int)sa[1]), ltB = wave_total_i32((int)sb[0] + (int)sb[1]);
        const int cA = TOTAL - ltA, cB = TOTAL - ltB;
        if (cA >= 256) loA = midA; else { hiA = midA; chiA = cA; }
        if (cB >= 256) loB = midB; else { hiB = midB; chiB = cB; } }
    constexpr int NI = 2 * ND;
#pragma unroll 1
    for (int rr = 0; rr < 2; ++rr) { const LAS unsigned char* krow = rr ? krowB : krowA; const int qsw = rr ? qswB : qswA; const int T = rr ? loB : loA, need = 256 - (rr ? chiB : chiA);
        int running = 0; unsigned long long myword = 0ull;
#pragma unroll
        for (int i = 0; i < NI; ++i) { const int kv = 64 * i + lane; int v = -32768; if (i < NT) v = *(const LAS short*)(krow + (((kv >> 2) ^ qsw) * 8) + (kv & 3) * 2);
            const bool eq = (v == T); const unsigned long long em = __ballot(eq);
            const int rank = running + (int)__builtin_amdgcn_mbcnt_hi((unsigned)(em >> 32), __builtin_amdgcn_mbcnt_lo((unsigned)em, 0u));
            const bool sel = (v > T) || (eq && rank < need); running += __popcll(em);
            const unsigned long long wd = __ballot(sel); if (lane == i) myword = wd; if ((i & 3) == 3) __builtin_amdgcn_sched_barrier(0); }
        if (rr) wordB = myword; else wordA = myword; }
}
typedef float f32x4m __attribute__((ext_vector_type(4)));
typedef _Float16 f16x8 __attribute__((ext_vector_type(8)));
__device__ __forceinline__ void idx_units(Frame& F, int b, int j, int nunits, const bf16* QI, const bf16* KI, const float* WI, unsigned long long* MASK) {
    const int wid = F.wave; const size_t rowbase = (size_t)b * SEQ;
    int tid = F.tid; asm volatile("" : "+v"(tid));
    LAS unsigned char* keys = F.lds + RING_OFF;
    LAS unsigned char* qlds = F.lds + RING_OFF + 65536;
#define IDX_UNIT(i) (32 * (((i) & 7) >> 1) + ((((i) & 7) & 1) ? 31 - j : j))
#define IDX_QSRC(u, c) (QI + (rowbase + 16 * (u) + ((c) & 15)) * 512 + (((c) >> 6) >> 1) * 64 + 32 * (((c) >> 6) & 1) + 8 * (((c) & 63) >> 4))
    { const int u0 = IDX_UNIT(0); const v4u c0 = *(const v4u*)IDX_QSRC(u0, tid), c1 = *(const v4u*)IDX_QSRC(u0, tid + 512);
      *(LAS v4u*)(qlds + tid * 16) = c0; *(LAS v4u*)(qlds + (tid + 512) * 16) = c1; }
    __syncthreads();
#pragma unroll 1
    for (int iu = 0; iu < nunits; ++iu) {
        int lane = F.lane; asm volatile("" : "+v"(lane));
        const int q16 = lane & 15, g = lane >> 4;
        const int u = IDX_UNIT(iu), q0 = 16 * u, NT = (u >> 2) + 1, NB = 4 * NT, t_q = q0 + q16;
        const LAS unsigned char* qcur = qlds + (iu & 1) * 16384 + lane * 16;
        const f32x4 w0 = *(const f32x4*)(WI + (rowbase + q0 + q16) * 8), w1 = *(const f32x4*)(WI + (rowbase + q0 + q16) * 8 + 4);
        const bf16* kbase = KI + (rowbase + q16) * 64 + 8 * g;
        f16x8 kf[4][2], kn[4][2];
#define IDX_LOADK(dst, bb0) do { _Pragma("unroll") for (int k = 0; k < 4; ++k) { int bb_ = (bb0) + 8 * k; bb_ = bb_ < NB ? bb_ : NB - 1; \
            _Pragma("unroll") for (int s = 0; s < 2; ++s) dst[k][s] = *(const f16x8*)(kbase + (size_t)bb_ * 1024 + 32 * s); } } while (0)
#ifdef IDX_PROBE_SELECT_ONLY
        const int NBx = (iu >= 8) ? 0 : NB;
#else
        const int NBx = NB;
#endif
        IDX_LOADK(kf, wid);
#pragma unroll 1
        for (int bb0 = wid; bb0 < NBx; bb0 += 32) {
            IDX_LOADK(kn, bb0 + 32 < NB ? bb0 + 32 : bb0);
            f32x4m a[4];
#pragma unroll
            for (int k = 0; k < 4; ++k) a[k] = (f32x4m){0.f, 0.f, 0.f, 0.f};
#pragma unroll
            for (int h = 0; h < 8; ++h) { f32x4m sc[4];
                const f16x8 qf0 = *(const LAS f16x8*)(qcur + (h * 2) * 1024), qf1 = *(const LAS f16x8*)(qcur + (h * 2 + 1) * 1024);
#pragma unroll
                for (int k = 0; k < 4; ++k) { sc[k] = (f32x4m){0.f, 0.f, 0.f, 0.f};
                    sc[k] = __builtin_amdgcn_mfma_f32_16x16x32_f16(kf[k][0], qf0, sc[k], 0, 0, 0); sc[k] = __builtin_amdgcn_mfma_f32_16x16x32_f16(kf[k][1], qf1, sc[k], 0, 0, 0); }
                const float wh = (h < 4) ? w0[h & 3] : w1[h & 3];
#pragma unroll
                for (int k = 0; k < 4; ++k)
#pragma unroll
                    for (int r = 0; r < 4; ++r) a[k][r] = fmaf(fmaxf(sc[k][r], 0.f), wh, a[k][r]);
                if (h & 1) __builtin_amdgcn_sched_barrier(0); }
#pragma unroll
            for (int k = 0; k < 4; ++k) { const int bb = bb0 + 8 * k;
                if (bb < NB) { const int kvb = 16 * bb + 4 * g; unsigned kk[4];
#pragma unroll
                    for (int r = 0; r < 4; ++r) { const _Float16 hf = (_Float16)a[k][r]; short bits = __builtin_bit_cast(short, hf); short key = (bits < 0) ? (short)(bits ^ 0x7fff) : bits;
                        if (kvb + r > t_q) key = (short)-32768; kk[r] = (unsigned)(unsigned short)key; }
                    const int gidx = 4 * bb + g;
                    typedef unsigned u32x2v __attribute__((ext_vector_type(2)));
                    *(LAS u32x2v*)(keys + q16 * 4096 + ((gidx ^ q16) * 8)) = (u32x2v){kk[0] | (kk[1] << 16), kk[2] | (kk[3] << 16)}; } }
#pragma unroll
            for (int k = 0; k < 4; ++k)
#pragma unroll
                for (int s = 0; s < 2; ++s) kf[k][s] = kn[k][s];
        }
        __syncthreads();
        v4u nq0 = (v4u){0u, 0u, 0u, 0u}, nq1 = nq0;
        if (iu + 1 < nunits) { const int un = IDX_UNIT(iu + 1); nq0 = *(const v4u*)IDX_QSRC(un, tid); nq1 = *(const v4u*)IDX_QSRC(un, tid + 512); }
        asm volatile("" : "+v"(lane));
        { const int qa = 2 * wid, qb = 2 * wid + 1, ta = q0 + qa, tb = q0 + qb; unsigned long long wa, wb;
#ifdef IDX_PROBE_SCORE_ONLY
          if (iu >= 8) { wa = 0ull; wb = 0ull; } else
#endif
          if (tb < 256) { const int lo = 64 * lane;
              wa = (ta >= lo + 63) ? ~0ull : (ta < lo) ? 0ull : ((2ull << (ta - lo)) - 1ull); wb = (tb >= lo + 63) ? ~0ull : (tb < lo) ? 0ull : ((2ull << (tb - lo)) - 1ull); }
          else { const LAS unsigned char* ka = keys + qa * 4096; const LAS unsigned char* kb = keys + qb * 4096;
              if (NT <= 8) select_rows2<4>(ka, kb, qa & 15, qb & 15, NT, lane, wa, wb); else if (NT <= 16) select_rows2<8>(ka, kb, qa & 15, qb & 15, NT, lane, wa, wb);
              else if (NT <= 24) select_rows2<12>(ka, kb, qa & 15, qb & 15, NT, lane, wa, wb); else select_rows2<16>(ka, kb, qa & 15, qb & 15, NT, lane, wa, wb); }
          unsigned long long* mdst = (iu >= 8) ? MASK + (size_t)(48u << 20) : MASK;
          if (lane < 32) { mdst[(rowbase + ta) * 32 + lane] = wa; mdst[(rowbase + tb) * 32 + lane] = wb; } }
        if (iu + 1 < nunits) { LAS unsigned char* qn = qlds + ((iu + 1) & 1) * 16384; *(LAS v4u*)(qn + tid * 16) = nq0; *(LAS v4u*)(qn + (tid + 512) * 16) = nq1; }
        __syncthreads();
    }
#undef IDX_UNIT
#undef IDX_QSRC
#undef IDX_LOADK
}

__device__ __forceinline__ void p6_final(Frame& F, float* out, const float* RSQ, const float* fgain) {
    const int gw = F.vcu * NWAVES + F.wave, NGW = F.G * NWAVES;
    f32x4 gv[4];
#pragma unroll
    for (int j = 0; j < 4; ++j) gv[j] = *(const f32x4*)(fgain + 4 * F.lane + 256 * j);
    for (int row = gw; row < M_TOK; row += NGW) {
        const float p = (F.lane < 16) ? RSQ[(size_t)row * 16 + F.lane] : 0.f;
        const float rinv = 1.0f / sqrtf(wave_sum(p) * (1.0f / 1024.0f) + RMS_EPS);
        GAS f32x4* zr = (GAS f32x4*)(out + (size_t)row * 1024) + F.lane;
        f32x4 v[4];
#pragma unroll
        for (int j = 0; j < 4; ++j) v[j] = zr[64 * j];
#pragma unroll
        for (int j = 0; j < 4; ++j) zr[64 * j] = v[j] * rinv * gv[j];
    }
}

struct Args { const float* in[9]; float* out; unsigned char* ws; int ph_lo, ph_hi; };
static_assert(sizeof(Args) == 9 * 8 + 8 + 8 + 8, "Args has no padding bytes");
__global__ void __launch_bounds__(NWAVES * 64, 2) mega_fwd(Args args) {
    extern __shared__ __attribute__((aligned(16))) unsigned char lds[];
    Frame F;
    F.lds = (LAS unsigned char*)lds;
    F.MISC = (volatile LAS unsigned*)(F.lds + MISC_OFF);
    F.tid = threadIdx.x; F.lane = F.tid & 63; F.wave = __builtin_amdgcn_readfirstlane(F.tid >> 6);
    F.G = gridDim.x; { const int bx = blockIdx.x; F.vcu = (F.G % 8 == 0) ? (bx % 8) * (F.G / 8) + bx / 8 : bx; }
    typedef const __attribute__((address_space(4))) Args* kargs_p;
#define KARGS(A) kargs_p A = (kargs_p)__builtin_amdgcn_kernarg_segment_ptr(); asm volatile("" : "+s"(A))
#define WSP(T, off) ((T*)(A->ws + (off)))
    gu32* ctl = (gu32*)(args.ws + WS_CTL);
    for (int u = F.tid; u < (LDS_BYTES - LDSCTL_OFF) / 4; u += NWAVES * 64) ((LAS unsigned*)(F.lds + LDSCTL_OFF))[u] = 0u;
    __syncthreads();
    XcdBarrier bar; bar.bar = (unsigned*)(ctl + CW_BAR); bar.x = 0; bar.st = nullptr;
    if (N_LAUNCHES == 1) bar = xcd_barrier_post((unsigned*)(ctl + CW_BAR), F.MISC + 8);
    const int lo = args.ph_lo, hi = args.ph_hi;
#define IN(k) (lo <= (k) && (k) < hi)
#define SEAM(k) do { if (IN(k) && IN((k) + 1)) xcd_barrier(bar); } while (0)
#ifndef REPEAT_PHASE
#define REPEAT_PHASE -1
#endif
#ifdef REPEAT_FOX
constexpr int N_FOX_UNITS = 8;
#else
constexpr int N_FOX_UNITS = 4;
#endif
#ifdef REPEAT_IDX
constexpr int N_IDX_UNITS = 16;
#else
constexpr int N_IDX_UNITS = 8;
#endif
#define REP(k) _Pragma("unroll 1") for (int rep_ = 0; rep_ < ((REPEAT_PHASE == (k)) ? 2 : 1); ++rep_, ((REPEAT_PHASE == (k)) && rep_ < 2 ? (xcd_barrier(bar), 0) : 0))

    if (IN(0)) REP(0) { KARGS(A); p0_prologue(F, A->in[1], A->in[2], A->in[5], A->in[7], WSP(float, WS_MODP), WSP(bf16, WS_WIN), WSP(bf16, WS_WOUT)); } SEAM(0);
    if (IN(1)) REP(1) { KARGS(A); p1_norm(F, A->in[0], A->in[3], A->in[4], WSP(float, WS_MODP), WSP(float, WS_GATE), WSP(bf16, WS_XN)); } SEAM(1);
    if (IN(2)) REP(2) {
        KARGS(A);
        pg8::Gemm g{WSP(bf16, WS_XN), WSP(bf16, WS_WIN), M_TOK, N_INP, 1024}; pg8::StaticOrder S; S.init(M_TOK, N_INP, F.G, (int)blockIdx.x);
        pg8::EpiIn E{WSP(bf16, WS_Q), WSP(bf16, WS_K), WSP(bf16, WS_V), WSP(bf16, WS_G), WSP(bf16, WS_QI), WSP(bf16, WS_KI), WSP(float, WS_FL), WSP(float, WS_WI), A->in[6]};
        pg8::gemm_phase<pg8::EpiIn, pg8::StaticOrder, true, true>(F.lds + RING_OFF, g, S, E);
    } SEAM(2);
    if (IN(3)) REP(3) {
#ifndef NO_FOX
        { KARGS(A); const attn_body::bf16* QB = WSP(const attn_body::bf16, WS_Q); const attn_body::bf16* KB = WSP(const attn_body::bf16, WS_K); const attn_body::bf16* VB = WSP(const attn_body::bf16, WS_V);
          const attn_body::bf16* GB = WSP(const attn_body::bf16, WS_G); attn_body::bf16* OB = WSP(attn_body::bf16, WS_XN);
          const int bh = F.vcu >> 1, b = bh >> 3, h = bh & 7, sel = F.vcu & 1;
          fox_prologue(F, WSP(const float, WS_FL), (const bf16*)QB, (const bf16*)KB, b, h);
          const float* kbl = (const float*)(lds + UP_OFF);
#pragma unroll 1
          for (int i_ = 0; i_ < N_FOX_UNITS; ++i_) { const int i = i_ & 3; const int qb = sel ? ((i == 0) ? 1 : (i == 1) ? 6 : (i == 2) ? 2 : 5) : ((i == 0) ? 0 : (i == 1) ? 7 : (i == 2) ? 3 : 4);
              const int t0 = __builtin_amdgcn_readfirstlane(fox_first_tile(F, qb));
              attn_body::attn_unit<8, 0>(b, h, qb, QB, KB, VB, OB, GB, (char*)lds + RING_OFF, kbl, 0.f, nullptr, t0); }
          __syncthreads(); }
#endif
#ifndef NO_IDX
        { KARGS(A); const bf16* QIB = WSP(const bf16, WS_QI); const bf16* KI = WSP(const bf16, WS_KI); const float* WI = WSP(const float, WS_WI); unsigned long long* MASK = WSP(unsigned long long, WS_MASK);
          const int b = F.vcu >> 4, j = F.vcu & 15;
          idx_units(F, b, j, N_IDX_UNITS, QIB, KI, WI, MASK); }
#endif
    } SEAM(3);
    if (IN(4)) REP(4) {
#ifndef NO_DSA
        KARGS(A); const attn_body::bf16* QB = WSP(const attn_body::bf16, WS_Q); const attn_body::bf16* KB = WSP(const attn_body::bf16, WS_K); const attn_body::bf16* VB = WSP(const attn_body::bf16, WS_V);
        const attn_body::bf16* GB = WSP(const attn_body::bf16, WS_G); attn_body::bf16* OB = WSP(attn_body::bf16, WS_XN); const unsigned long long* MASK = WSP(const unsigned long long, WS_MASK);
        const int bh = F.vcu >> 1, b = bh >> 3, hh = bh & 7, sel = F.vcu & 1;
        const float slope2 = exp2f(-(float)(hh + 1)) * LOG2E;
        const unsigned long long* Mb = MASK + (size_t)b * SEQ * 32;
#pragma unroll 1
        for (int i = 0; i < 4; ++i) { const int qb = sel ? ((i == 0) ? 1 : (i == 1) ? 6 : (i == 2) ? 2 : 5) : ((i == 0) ? 0 : (i == 1) ? 7 : (i == 2) ? 3 : 4);
            attn_body::attn_unit<8, 1>(b, 8 + hh, qb, QB, KB, VB, OB, GB, (char*)lds + RING_OFF, nullptr, slope2, Mb, 0); }
        __syncthreads();
#endif
    } SEAM(4);
    if (IN(5)) REP(5) {
        KARGS(A);
        pg8::Gemm g{WSP(bf16, WS_XN), WSP(bf16, WS_WOUT), M_TOK, 1024, 1024}; pg8::StaticOrder S; S.init(M_TOK, 1024, F.G, (int)blockIdx.x);
        pg8::EpiOut E{A->in[0], A->out, WSP(float, WS_GATE), WSP(float, WS_RSQ)};
        pg8::gemm_phase<pg8::EpiOut, pg8::StaticOrder, true, true>(F.lds + RING_OFF, g, S, E);
    } SEAM(5);
    if (IN(6)) { KARGS(A); p6_final(F, A->out, WSP(float, WS_RSQ), A->in[8]); }
#undef IN
#undef SEAM
#undef KARGS
#undef WSP
}

extern "C" void kernel_launch(void* const* d_in, const int* in_sizes, int n_in, void* d_out, int out_size, void* d_ws, size_t ws_size, hipStream_t stream) {
    static int grid = 0;
    if (grid == 0) {
        if (n_in != 9 || in_sizes[0] != M_TOK * DMODEL || out_size != M_TOK * DMODEL || ws_size < WS_END) { fprintf(stderr, "kernel_launch: unexpected shapes (n_in %d, in0 %d, out %d, ws %zu); nothing launched\n", n_in, n_in > 0 ? in_sizes[0] : -1, out_size, ws_size); grid = -1; return; }
        int dev = 0, cus = 0, per_cu = 0;
        if (hipGetDevice(&dev) != hipSuccess || hipDeviceGetAttribute(&cus, hipDeviceAttributeMultiprocessorCount, dev) != hipSuccess) { grid = -1; return; }
        if (hipFuncSetAttribute((const void*)mega_fwd, hipFuncAttributeMaxDynamicSharedMemorySize, LDS_BYTES) != hipSuccess) { fprintf(stderr, "kernel_launch: hipFuncSetAttribute failed\n"); grid = -1; return; }
        if (hipOccupancyMaxActiveBlocksPerMultiprocessor(&per_cu, (const void*)mega_fwd, NWAVES * 64, LDS_BYTES) != hipSuccess || per_cu < 1)
            fprintf(stderr, "kernel_launch: note: occupancy query reports %d workgroups per CU\n", per_cu);
        (void)hipGetLastError();
        grid = cus;
        if (grid != 256) fprintf(stderr, "kernel_launch: %d CUs; the static unit orders assume 256\n", grid);
    }
    if (grid < 0) return;
    if (hipMemsetAsync((char*)d_ws + WS_CTL, 0, CTL_ZERO_BYTES, stream) != hipSuccess) { fprintf(stderr, "kernel_launch: memset failed\n"); return; }
    Args a{};
    for (int i = 0; i < 9; ++i) a.in[i] = (const float*)d_in[i];
    a.out = (float*)d_out; a.ws = (unsigned char*)d_ws;
    if (N_LAUNCHES == 1) { a.ph_lo = 0; a.ph_hi = N_PHASES; hipLaunchKernelGGL(mega_fwd, dim3(grid), dim3(NWAVES * 64), LDS_BYTES, stream, a); }
    else { for (int p = 0; p < N_PHASES; ++p) { a.ph_lo = p; a.ph_hi = p + 1; hipLaunchKernelGGL(mega_fwd, dim3(grid), dim3(NWAVES * 64), LDS_BYTES, stream, a); } }
    const hipError_t le = hipPeekAtLastError();
    if (le != hipSuccess) fprintf(stderr, "kernel_launch: launch failed: %s\n", hipGetErrorName(le));
}
```
